# Optimizing an MI355X kernel written in HIP

```python
import jax, jax.numpy as jnp
from jax import lax
import numpy as np

D_MODEL = 1024
BATCH = 16
SEQ = 2048
DEPTH = 2

N_HEADS = 16
HEAD_DIM = D_MODEL // N_HEADS
D_FF = 2816
N_EXPERTS = 8
TOP_K = 2
D_FF_EXPERT = 2816
N_META = 16
BLOCK = 128
EPS = 1e-6
FORGET_BIAS_OFFSET = 3.0
N_A = DEPTH // 2
N_B = DEPTH - N_A
N_DENSE = (DEPTH + 1) // 2
N_MOE = DEPTH // 2

kernel_name = "yoco_stickbreak_fox_moe_trunk"


def rms_norm(x, g):
    xf = x.astype(jnp.float32)
    y = xf * lax.rsqrt(jnp.mean(xf * xf, axis=-1, keepdims=True) + EPS)
    return (y * g.astype(jnp.float32)).astype(x.dtype)


def swiglu(h, w_gate_up, w_down):
    gu = h @ w_gate_up
    g, u = jnp.split(gu, 2, axis=-1)
    return (jax.nn.silu(g) * u) @ w_down


def causal_block_sweep(block_fn, q_inputs, kv_inputs):
    B, L = q_inputs[0].shape[0], q_inputs[0].shape[1]
    pos = jnp.arange(L, dtype=jnp.int32)
    out_meta = block_fn([t[:, :N_META] for t in q_inputs], pos[:N_META],
                        [t[:, :N_META] for t in kv_inputs], pos[:N_META])
    n_blocks = (L - N_META) // BLOCK

    def to_blocks(t):
        r = t[:, N_META:]
        r = r.reshape((B, n_blocks, BLOCK) + r.shape[2:])
        return jnp.moveaxis(r, 1, 0)

    q_blocks = [to_blocks(t) for t in q_inputs]
    pos_blocks = pos[N_META:].reshape(n_blocks, BLOCK)
    out_blocks = lax.map(lambda a: block_fn(a[0], a[1], kv_inputs, pos), (q_blocks, pos_blocks))
    out_real = jnp.moveaxis(out_blocks, 0, 1).reshape((B, n_blocks * BLOCK) + out_blocks.shape[3:])
    return jnp.concatenate([out_meta, out_real], axis=1)


def stick_breaking_block(q_list, qpos, kv_list, kpos):
    (q,) = q_list
    k, v = kv_list
    z = jnp.einsum('bqhd,bkhd->bhqk', q.astype(jnp.float32), k.astype(jnp.float32)) * (HEAD_DIM ** -0.5)
    mask = kpos[None, :] < qpos[:, None]
    log1m = jnp.where(mask, -jax.nn.softplus(z), 0.0)
    after = lax.cumsum(log1m, axis=3, reverse=True) - log1m
    a = jnp.where(mask, jnp.exp(jax.nn.log_sigmoid(z) + after), 0.0)
    return jnp.einsum('bhqk,bkhd->bqhd', a, v.astype(jnp.float32)).astype(v.dtype)


def forgetting_block(q_list, qpos, kv_list, kpos):
    q, fq = q_list
    k, v, fk = kv_list
    logits = jnp.einsum('bqhd,bkhd->bhqk', q.astype(jnp.float32), k.astype(jnp.float32)) * (HEAD_DIM ** -0.5)
    decay = jnp.transpose(fq, (0, 2, 1))[:, :, :, None] - jnp.transpose(fk, (0, 2, 1))[:, :, None, :]
    mask = kpos[None, :] <= qpos[:, None]
    p = jax.nn.softmax(jnp.where(mask, logits + decay, -jnp.inf), axis=-1)
    return jnp.einsum('bhqk,bkhd->bqhd', p, v.astype(jnp.float32)).astype(v.dtype)


def stick_breaking_mixer(h, g, w_qkv, w_o):
    B, L, _ = h.shape
    qkv = (rms_norm(h, g) @ w_qkv).reshape(B, L, 3, N_HEADS, HEAD_DIM)
    q, k, v = qkv[:, :, 0], qkv[:, :, 1], qkv[:, :, 2]
    o = causal_block_sweep(stick_breaking_block, [q], [k, v])
    return o.reshape(B, L, D_MODEL) @ w_o


def shared_kv_state(h, g, w_kvf, b_f, k_norm):
    B, L, _ = h.shape
    u = rms_norm(h, g) @ w_kvf
    k = rms_norm(u[..., :D_MODEL].reshape(B, L, N_HEADS, HEAD_DIM), k_norm)
    v = u[..., D_MODEL:2 * D_MODEL].reshape(B, L, N_HEADS, HEAD_DIM)
    f_logit = (u[..., 2 * D_MODEL:] + b_f).astype(jnp.float32)
    F = lax.cumsum(jax.nn.log_sigmoid(f_logit), axis=1)
    return k, v, F


def forgetting_mixer(h, g, w_q, q_norm, w_o, k, v, F):
    B, L, _ = h.shape
    q = rms_norm((rms_norm(h, g) @ w_q).reshape(B, L, N_HEADS, HEAD_DIM), q_norm)
    o = causal_block_sweep(forgetting_block, [q, F], [k, v, F])
    return o.reshape(B, L, D_MODEL) @ w_o


def moe_swiglu(h, w_router, w_gu, w_down):
    B, L, D = h.shape
    t = h.reshape(B * L, D)
    logits = (t @ w_router).astype(jnp.float32)
    top_vals, top_idx = lax.top_k(logits, TOP_K)
    gates = jax.nn.softmax(top_vals, axis=-1)
    combine = jnp.sum(jax.nn.one_hot(top_idx, N_EXPERTS, dtype=jnp.float32) * gates[..., None], axis=1)
    y = jnp.zeros_like(t)
    for e in range(N_EXPERTS):
        y = y + combine[:, e:e + 1].astype(t.dtype) * swiglu(t, w_gu[e], w_down[e])
    return y.reshape(B, L, D)


def setup_inputs(seed: int = 0) -> dict:
    key = jax.random.key(seed)
    ks = jax.random.split(key, 24)
    D, H = D_MODEL, N_HEADS

    def w(k, shape, fan_in):
        return jax.random.normal(k, shape, jnp.float32) * (fan_in ** -0.5)

    def gain(k, shape):
        return 1.0 + 0.1 * jax.random.normal(k, shape, jnp.float32)

    return {
        "x": jax.random.normal(ks[0], (BATCH, SEQ, D), jnp.float32),
        "meta_tokens": jax.random.normal(ks[1], (N_META, D), jnp.float32),
        "norm_attn_a": gain(ks[2], (N_A, D)),
        "w_qkv_a": w(ks[3], (N_A, D, 3 * D), D),
        "w_o_a": w(ks[4], (N_A, D, D), D),
        "norm_kv": gain(ks[5], (D,)),
        "w_kvf": w(ks[6], (D, 2 * D + H), D),
        "b_f": FORGET_BIAS_OFFSET + 0.5 * jax.random.normal(ks[7], (H,), jnp.float32),
        "k_norm": gain(ks[8], (HEAD_DIM,)),
        "norm_attn_b": gain(ks[9], (N_B, D)),
        "w_q_b": w(ks[10], (N_B, D, D), D),
        "q_norm_b": gain(ks[11], (N_B, HEAD_DIM)),
        "w_o_b": w(ks[12], (N_B, D, D), D),
        "norm_ffn_dense": gain(ks[13], (N_DENSE, D)),
        "w_gu_dense": w(ks[14], (N_DENSE, D, 2 * D_FF), D),
        "w_down_dense": w(ks[15], (N_DENSE, D_FF, D), D_FF),
        "norm_ffn_moe": gain(ks[16], (N_MOE, D)),
        "w_router": w(ks[17], (N_MOE, D, N_EXPERTS), D),
        "w_gu_moe": w(ks[18], (N_MOE, N_EXPERTS, D, 2 * D_FF_EXPERT), D),
        "w_down_moe": w(ks[19], (N_MOE, N_EXPERTS, D_FF_EXPERT, D), D_FF_EXPERT),
    }


def reference(x, meta_tokens, norm_attn_a, w_qkv_a, w_o_a, norm_kv, w_kvf, b_f, k_norm,
              norm_attn_b, w_q_b, q_norm_b, w_o_b, norm_ffn_dense, w_gu_dense, w_down_dense,
              norm_ffn_moe, w_router, w_gu_moe, w_down_moe):
    B = x.shape[0]
    meta = jnp.broadcast_to(meta_tokens.astype(x.dtype)[None], (B, N_META, D_MODEL))
    h = jnp.concatenate([meta, x], axis=1)
    k_sh = v_sh = F_sh = None
    for layer in range(DEPTH):
        if layer < N_A:
            h = h + stick_breaking_mixer(h, norm_attn_a[layer], w_qkv_a[layer], w_o_a[layer])
        else:
            if layer == N_A:
                k_sh, v_sh, F_sh = shared_kv_state(h, norm_kv, w_kvf, b_f, k_norm)
            i = layer - N_A
            h = h + forgetting_mixer(h, norm_attn_b[i], w_q_b[i], q_norm_b[i], w_o_b[i], k_sh, v_sh, F_sh)
        j = layer // 2
        if layer % 2 == 0:
            h = h + swiglu(rms_norm(h, norm_ffn_dense[j]), w_gu_dense[j], w_down_dense[j])
        else:
            h = h + moe_swiglu(rms_norm(h, norm_ffn_moe[j]), w_router[j], w_gu_moe[j], w_down_moe[j])
    return h[:, N_META:]
```

```cpp
#include <hip/hip_runtime.h>
#include <cstdio>
#include <cstdint>

#define GAS __attribute__((address_space(1)))
#define LAS __attribute__((address_space(3)))
typedef unsigned short bf16;
typedef short bf16x8 __attribute__((ext_vector_type(8)));
typedef short s16x4 __attribute__((ext_vector_type(4)));
typedef float f32x2 __attribute__((ext_vector_type(2)));
typedef float f32x4 __attribute__((ext_vector_type(4)));
typedef float f32x16 __attribute__((ext_vector_type(16)));
typedef unsigned u32x2 __attribute__((ext_vector_type(2)));
typedef unsigned u32x4 __attribute__((ext_vector_type(4)));
typedef __bf16 bf16x2_t __attribute__((ext_vector_type(2)));
typedef GAS unsigned gu32;

constexpr int NB = 16, SEQ = 2048, DM = 1024, NH = 16, HD = 64, FF = 2816, NE = 8, NMETA = 16;
constexpr int T = NB * SEQ;
constexpr int KROWS = 64 + SEQ;
constexpr float EPS = 1e-6f;
constexpr float LOG2E = 1.4426950408889634f;
constexpr float C2 = 0.125f * LOG2E;
constexpr float QS_H = 8.f, QS_WGU = 128.f, QS_ACT = 32.f, QS_WDN = 256.f;
constexpr int MOE_MAXTILES = 2 * T / 256 + NE;

constexpr size_t MiB = 1u << 20;
constexpr size_t ZERO_BYTES = 128 * 1024;
constexpr int CW_TMO = 0, CW_BAR = 4096, CW_CNT = 16384, CW_CMAX = 20480  , CM_GU0 = CW_CMAX, CM_QKV0 = CM_GU0 + 2 * FF, CM_QKV1 = CM_QKV0 + 3 * DM;
static_assert((CM_QKV1 + 3 * DM) * 4 <= (int)ZERO_BYTES, "cmax");
constexpr size_t Z_SS1 = 1 * MiB, Z_SS2 = Z_SS1 + 262144, Z_SS3 = Z_SS2 + 262144, Z_KSQM = Z_SS3 + 262144;
constexpr size_t WS_SS0 = 5 * MiB  , WS_LF = 6 * MiB, WS_LIST = 9 * MiB, WS_GLIST = 10 * MiB, WS_TOKINFO = 11 * MiB;
constexpr size_t WS_META = 12 * MiB;
constexpr size_t MO_QM = 0, MO_KM = 32768, MO_VM = 65536, MO_OM = 98304, MO_M1 = 131072, MO_M2 = 196608, MO_ACTM = 262144, MO_KMRAW = 360448;
constexpr size_t WS_WSM = 13 * MiB;
constexpr size_t WS_WQKV0 = 16 * MiB, WS_WO0 = 22 * MiB, WS_WGU0 = 24 * MiB, WS_WDN0 = 35 * MiB, WS_WQKV1 = 41 * MiB, WS_WO1 = 47 * MiB, WS_WGU1 = 49 * MiB  , WS_H8 = 96 * MiB  , WS_WDN1 = 148 * MiB  ;
constexpr size_t WS_WGU0Q = 176 * MiB;
constexpr size_t WS_WQKV1Q = 172 * MiB;
constexpr size_t WS_WDN0Q = 186 * MiB;
constexpr size_t WS_WQKV0Q = 182 * MiB;
constexpr size_t WS_RA0 = 5 * MiB + 512 * 1024;
constexpr size_t WS_C = 16 * MiB;
constexpr size_t WS_H = 192 * MiB;
constexpr size_t WS_Q = 256 * MiB, WS_K = 320 * MiB, WS_V = 386 * MiB, WS_ACT = 452 * MiB, WS_MACT = 256 * MiB;
constexpr size_t WS_END = 628 * MiB;
static_assert(WS_WGU1 + (size_t)NE * 2 * FF * DM <= WS_H8 && WS_H8 + (size_t)T * DM <= WS_WDN1 && WS_WDN1 + (size_t)NE * DM * FF <= WS_H, "weights");
static_assert(WS_C + (size_t)MOE_MAXTILES * 256 * DM * 2 <= WS_WDN1, "C overlay");
static_assert(WS_K + (size_t)NB * KROWS * DM * 2 <= WS_V && WS_V + (size_t)NB * KROWS * DM * 2 <= WS_ACT && WS_ACT + (size_t)T * FF * 2 <= WS_END, "acts");
static_assert(WS_MACT + (size_t)MOE_MAXTILES * 256 * FF * 2 <= WS_END, "moe act");
static_assert(WS_LF + (size_t)NB * NH * KROWS * 4 <= WS_LIST, "lf");

constexpr int RING_BYTES = 131072;
constexpr int L_MISC = RING_BYTES;
constexpr int L_TAB = RING_BYTES + 256;
constexpr int L_X = RING_BYTES + 2048;
constexpr int L_RS = L_X + 8192;
constexpr int RS_PAR = 4096;
constexpr int LDS_BYTES = 151552;
static_assert(L_RS + 2 * RS_PAR <= LDS_BYTES && L_TAB + 296 * 4 <= L_X, "lds map");

#define RLX_AGENT __ATOMIC_RELAXED, __HIP_MEMORY_SCOPE_AGENT
#define LDS_WAIT() asm volatile("s_waitcnt lgkmcnt(0)" ::: "memory")
#define VM_WAIT() asm volatile("s_waitcnt vmcnt(0)" ::: "memory")
__device__ __forceinline__ unsigned f2bf(float f) { unsigned u = __builtin_bit_cast(unsigned, f); return (u + 0x7fffu + ((u >> 16) & 1u)) >> 16; }
__device__ __forceinline__ unsigned pk2(float lo, float hi) { return f2bf(lo) | (f2bf(hi) << 16); }
__device__ __forceinline__ float bflo(unsigned u) { return __builtin_bit_cast(float, u << 16); }
__device__ __forceinline__ float bfhi(unsigned u) { return __builtin_bit_cast(float, u & 0xffff0000u); }
__device__ __forceinline__ float bf2f(bf16 v) { return __builtin_bit_cast(float, (unsigned)v << 16); }
__device__ __forceinline__ unsigned cvt_pk_bf16(float lo, float hi) { unsigned r; asm volatile("v_cvt_pk_bf16_f32 %0, %1, %2" : "=v"(r) : "v"(lo), "v"(hi)); return r; }
__device__ __forceinline__ unsigned cvtpk_s(float lo, float hi) { f32x2 v = {lo, hi}; bf16x2_t b = __builtin_convertvector(v, bf16x2_t); return __builtin_bit_cast(unsigned, b); }
__device__ __forceinline__ float fexp2(float x) { return __builtin_amdgcn_exp2f(x); }
__device__ __forceinline__ float frcp(float x) { return __builtin_amdgcn_rcpf(x); }
__device__ __forceinline__ float frsq(float x) { return __builtin_amdgcn_rsqf(x); }
typedef unsigned long long u64;
typedef int v8i __attribute__((ext_vector_type(8)));
typedef int v4i_t __attribute__((ext_vector_type(4)));
__device__ __forceinline__ float clamp8(float x) { return __builtin_amdgcn_fmed3f(x, -448.f, 448.f); }
__device__ __forceinline__ unsigned pk4_fp8(float a, float b, float c, float d) { int p = __builtin_amdgcn_cvt_pk_fp8_f32(clamp8(a), clamp8(b), 0, false); p = __builtin_amdgcn_cvt_pk_fp8_f32(clamp8(c), clamp8(d), p, true); return (unsigned)p; }
constexpr float FXS = 1048576.f, FXI = 1.f / 1048576.f;
__device__ __forceinline__ u64 to_fx(float s) { return (u64)(s * FXS); }
__device__ __forceinline__ float from_fx(u64 v) { return (float)v * FXI; }
__device__ __forceinline__ void dma4(const void* g, LAS unsigned* l) { __builtin_amdgcn_global_load_lds((const unsigned*)g, l, 4, 0, 0); }
__device__ __forceinline__ float rs_from_planes(const LAS unsigned* RS, int r) { const float v = (float)RS[r] + (float)RS[256 + r] * 4294967296.f; return frsq(v * (FXI / 1024.f) + 1e-6f); }

__device__ __forceinline__ unsigned q8bits(float x) { return __builtin_bit_cast(unsigned, __builtin_amdgcn_fmed3f(x, -127.f, 127.f) + 12582912.f); }
__device__ __forceinline__ unsigned pk4_i8(float a, float b, float c, float d) {
    return (q8bits(a) & 0xffu) | ((q8bits(b) & 0xffu) << 8) | ((q8bits(c) & 0xffu) << 16) | (q8bits(d) << 24); }
constexpr float CQ = 6.f;
__device__ __forceinline__ float ms_from_planes(const LAS unsigned* RS, int r) { return ((float)RS[r] + (float)RS[256 + r] * 4294967296.f) * (FXI / 1024.f) + 1e-6f; }
__device__ __forceinline__ void glds16s(const void* base, unsigned voff, unsigned lds_dst) {
    asm volatile("s_mov_b32 m0, %2\n\ts_nop 0\n\tglobal_load_lds_dwordx4 %0, %1" : : "v"(voff), "s"(base), "s"(lds_dst) : "memory", "m0"); }

namespace pg8 {
constexpr int BM = 256, BK = 64, HALF = 128, HTB = HALF * BK * 2, STAGE_BYTES = 8 * HTB, NXCD = 8, WGM = 8;
__host__ __device__ __forceinline__ int lds_byte(int r, int c) { const int st = (r >> 4) * 2 + (c >> 5), rr = r & 15, cc = c & 31, ob = rr * 64 + cc * 2; return st * 1024 + (ob ^ (((ob >> 9) & 1) << 5)); }
__host__ __device__ __forceinline__ void stage_rc(int b, int& R, int& C) { const int st = b / 1024, sb = b % 1024, swz = sb ^ (((sb >> 9) & 1) << 5); R = (st >> 1) * 16 + swz / 64; C = (st & 1) * 32 + (swz % 64) / 2; }
__host__ __device__ __forceinline__ int perm32(int rho) { const int n = rho >> 4, i = rho & 15; return 8 * (i >> 2) + 4 * n + (i & 3); }
struct Unit { int pm, pn; };
__device__ __forceinline__ bool order_next(int i, int G, int c, int nM, int nN, Unit& u) {
    const int nwg = nM * nN; const long L = (long)i * G + c; if (L >= nwg) return false;
    int wgid = (int)L; { const int q = nwg / NXCD, r = nwg % NXCD, xcd = wgid % NXCD, off = wgid / NXCD; wgid = (xcd < r ? xcd * (q + 1) : r * (q + 1) + (xcd - r) * q) + off; }
    const int nig = WGM * nN, gid = wgid / nig, fm = gid * WGM, gsz = (nM - fm) < WGM ? (nM - fm) : WGM;
    u.pm = fm + ((wgid % nig) % gsz); u.pn = (wgid % nig) / gsz; return true;
}
struct DenseSched {
    static constexpr bool GATHER = false;
    int nM, nN, G, c; const char* A; const char* Bt; size_t tsA, tsB;
    __device__ __forceinline__ bool next(int i, Unit& u) const { return order_next(i, G, c, nM, nN, u); }
    __device__ __forceinline__ const char* a_base(const Unit& u) const { return A + (size_t)u.pm * tsA; }
    __device__ __forceinline__ const char* b_base(const Unit& u) const { return Bt + (size_t)u.pn * tsB; }
    __device__ __forceinline__ int a_row(const Unit&, int r) const { return r; }
    __device__ __forceinline__ const int* list_ptr(const Unit&, int) const { return nullptr; }
    __device__ __forceinline__ bool row_valid(const Unit&, int) const { return true; }
};
template <bool GATHER_> struct MoeSched {
    static constexpr bool GATHER = GATHER_;
    int nM, nN, G, c; const char* A; const char* Bt; size_t tsA, tsB, esB; const LAS int* tab; const int* list; const float* glist;
    __device__ __forceinline__ bool next(int i, Unit& u) const { return order_next(i, G, c, nM, nN, u); }
    __device__ __forceinline__ const char* a_base(const Unit& u) const { return GATHER_ ? A : A + (size_t)u.pm * tsA; }
    __device__ __forceinline__ const char* b_base(const Unit& u) const { return Bt + (size_t)tab[u.pm] * esB + (size_t)u.pn * tsB; }
    __device__ __forceinline__ int a_row(const Unit& u, int r) const { const int e = tab[u.pm], lr = (u.pm - tab[272 + e]) * 256 + r; return lr < tab[288 + e] ? list[(size_t)e * T + lr] : 0; }
    __device__ __forceinline__ const int* list_ptr(const Unit& u, int r) const { const int e = tab[u.pm]; return list + (size_t)e * T + (u.pm - tab[272 + e]) * 256 + r; }
    __device__ __forceinline__ const float* gate_ptr(const Unit& u, int r) const { const int e = tab[u.pm]; return glist + (size_t)e * T + (u.pm - tab[272 + e]) * 256 + r; }
    __device__ __forceinline__ bool row_valid(const Unit& u, int r) const { const int e = tab[u.pm]; return (u.pm - tab[272 + e]) * 256 + r < tab[288 + e]; }
    __device__ __forceinline__ float gate(const Unit& u, int r) const { const int e = tab[u.pm], lr = (u.pm - tab[272 + e]) * 256 + r; return lr < tab[288 + e] ? glist[(size_t)e * T + lr] : 0.f; }
};

template <class Epi, class Sched, bool ALIGN_EPI, int MODE = 0>
__device__ __forceinline__ void gemm_phase(LAS unsigned char* lds, const int KB, const Sched& S, const Epi& E) {
    constexpr bool FP8 = (MODE == 1);
    int tid_ = threadIdx.x; asm volatile("" : "+v"(tid_));
    const int tid = tid_, wid = __builtin_amdgcn_readfirstlane(tid >> 6), lane = tid & 63, wr = wid >> 2, wc = wid & 3, fr = lane & 15, fq = lane >> 4;
    const int nt = KB / 128;
    unsigned voffB[2];
#pragma unroll
    for (int i = 0; i < 2; ++i) { int R, C; stage_rc(tid * 16 + i * 8192, R, C); const int Rb = (R & ~31) + perm32(R & 31); voffB[i] = (unsigned)(Rb * KB + C * 2); }
    const size_t kstep = (size_t)(BK * 2);
    const size_t hstep = (size_t)HALF * KB;
    const unsigned ldsw = (unsigned)wid * 1024u; const unsigned lds0 = (unsigned)(uintptr_t)lds;
    const int aoff = lds_byte(wr * 64 + fr, fq * 8), boff = lds_byte(wc * 32 + fr, fq * 8);
#define PG8_SA(b, h) (((b) * 2 + (h)) * HTB)
#define PG8_SB(b, h) ((4 + (b) * 2 + (h)) * HTB)
#define PG8_STAGE(bufoff, gbase, voff) do { _Pragma("unroll") for (int _i = 0; _i < 2; ++_i) { \
        if constexpr (FP8) glds16s((const void*)(gbase), (voff)[_i], (unsigned)__builtin_amdgcn_readfirstlane((int)(lds0 + (unsigned)(bufoff) + ldsw + _i * 8192))); \
        else __builtin_amdgcn_global_load_lds((const unsigned*)((const char*)(gbase) + (voff)[_i]), (LAS unsigned*)(lds + (bufoff) + ldsw + _i * 8192), 16, 0, 0); } } while (0)
#define PG8_LD16(base, off) (*(const LAS v4i_t*)(size_t)((base) + (unsigned)(off)))
#define PG8_LD16B(base, off) (*(const LAS bf16x8*)(size_t)((base) + (unsigned)(off)))
#define PG8_LDA(dst, b, h) do { _Pragma("unroll") for (int m = 0; m < 4; ++m) { if constexpr (FP8) dst##8[m] = __builtin_shufflevector(PG8_LD16(ab, PG8_SA(b, h) + m * 2048), PG8_LD16(ab, PG8_SA(b, h) + m * 2048 + 1024), 0, 1, 2, 3, 4, 5, 6, 7); \
        else { _Pragma("unroll") for (int k = 0; k < 2; ++k) dst[m][k] = PG8_LD16B(ab, PG8_SA(b, h) + m * 2048 + k * 1024); } } } while (0)
#define PG8_LDB(dst, b, h) do { _Pragma("unroll") for (int n = 0; n < 2; ++n) { if constexpr (FP8) dst##8[n] = __builtin_shufflevector(PG8_LD16(bb, PG8_SB(b, h) + n * 2048), PG8_LD16(bb, PG8_SB(b, h) + n * 2048 + 1024), 0, 1, 2, 3, 4, 5, 6, 7); \
        else { _Pragma("unroll") for (int k = 0; k < 2; ++k) dst[n][k] = PG8_LD16B(bb, PG8_SB(b, h) + n * 2048 + k * 1024); } } } while (0)
#define PG8_MMA(ai, bj, At, Bt) do { __builtin_amdgcn_s_setprio(1); _Pragma("unroll") for (int m = 0; m < 4; ++m) _Pragma("unroll") for (int n = 0; n < 2; ++n) { \
        if constexpr (FP8) asm volatile("v_mfma_scale_f32_16x16x128_f8f6f4 %0, %1, %2, %0, %3, %3 op_sel_hi:[0,0,0]" : "+v"(acc[ai][bj][m][n]) : "v"(Bt##8[n]), "v"(At##8[m]), "v"(sc1)); \
        else if constexpr (MODE == 2) { _Pragma("unroll") for (int k = 0; k < 2; ++k) acc[ai][bj][m][n] = __builtin_bit_cast(f32x4, __builtin_amdgcn_mfma_i32_16x16x64_i8(__builtin_bit_cast(v4i_t, Bt[n][k]), __builtin_bit_cast(v4i_t, At[m][k]), __builtin_bit_cast(v4i_t, acc[ai][bj][m][n]), 0, 0, 0)); } \
        else { _Pragma("unroll") for (int k = 0; k < 2; ++k) acc[ai][bj][m][n] = __builtin_amdgcn_mfma_f32_16x16x32_bf16(Bt[n][k], At[m][k], acc[ai][bj][m][n], 0, 0, 0); } } \
        __builtin_amdgcn_s_setprio(0); } while (0)
#define PG8_WAIT_V(n) asm volatile("s_waitcnt vmcnt(" #n ")" ::: "memory")
#define PG8_WAIT_L(n) asm volatile("s_waitcnt lgkmcnt(" #n ")" ::: "memory")
#define PG8_BAR __builtin_amdgcn_s_barrier()
#define PG8_SCHED __builtin_amdgcn_sched_barrier(0)
#define PG8_SETV(v, u) do { int t2_ = threadIdx.x; asm volatile("" : "+v"(t2_)); _Pragma("unroll") for (int _i = 0; _i < 2; ++_i) { int R_, C_; stage_rc(t2_ * 16 + _i * 8192, R_, C_); \
        _Pragma("unroll") for (int _h = 0; _h < 2; ++_h) { const int row_ = Sched::GATHER ? S.a_row(u, R_ + HALF * _h) : (R_ + HALF * _h); v[_h][_i] = (unsigned)(row_ * KB + C_ * 2); } } } while (0)
    Unit cur, nxt; int ui = 0;
    if (!S.next(0, cur)) return;
    f32x4 acc[2][2][4][2];
#pragma unroll
    for (int a = 0; a < 2; ++a)
#pragma unroll
        for (int b = 0; b < 2; ++b)
#pragma unroll
            for (int m = 0; m < 4; ++m)
#pragma unroll
                for (int n = 0; n < 2; ++n) acc[a][b][m][n] = (f32x4){0.f, 0.f, 0.f, 0.f};
    bf16x8 At[4][2], B0[2][2], B1[2][2]; v8i At8[4], B08[2], B18[2];
    int sc1 = 0x7f7f7f7f; asm volatile("" : "+v"(sc1));
    unsigned vA[2][2], vN[2][2];
    PG8_SETV(vA, cur);
#pragma unroll
    for (int h = 0; h < 2; ++h)
#pragma unroll
        for (int i = 0; i < 2; ++i) vN[h][i] = vA[h][i];
    const char* cA = S.a_base(cur); const char* cB = S.b_base(cur);
    PG8_STAGE(PG8_SB(0, 0), cB, voffB); PG8_STAGE(PG8_SB(0, 1), cB + hstep, voffB); PG8_STAGE(PG8_SA(0, 0), cA, vA[0]); PG8_STAGE(PG8_SA(0, 1), cA, vA[1]);
    if (wr == 1) PG8_BAR;
    PG8_WAIT_V(2); PG8_BAR;
    PG8_STAGE(PG8_SB(1, 0), cB + kstep, voffB); PG8_STAGE(PG8_SA(1, 0), cA + kstep, vA[0]); PG8_STAGE(PG8_SB(1, 1), cB + hstep + kstep, voffB);
    PG8_WAIT_V(6); PG8_BAR;
    for (;;) {
        const bool has_next = S.next(ui + 1, nxt);
        const char* nA = has_next ? S.a_base(nxt) : cA; const char* nB = has_next ? S.b_base(nxt) : cB;
        if constexpr (Sched::GATHER) { if (has_next) PG8_SETV(vN, nxt); }
        if (Epi::HAS_RS && wid < 4) E.pf0(cur, S, (int)threadIdx.x, (LAS unsigned*)(lds + L_RS + (ui & 1) * RS_PAR + wid * 256));
#pragma unroll 1
        for (int t = 0; t < nt; t += 2) {
            const bool last = (t == nt - 2);
            unsigned ab = lds0 + (unsigned)aoff, bb = lds0 + (unsigned)boff; asm volatile("" : "+v"(ab), "+v"(bb));
            const char* a1 = cA + (size_t)(t + 1) * kstep;
            const char* a2 = last ? nA : cA + (size_t)(t + 2) * kstep; const char* b2 = last ? nB : cB + (size_t)(t + 2) * kstep;
            const char* a3 = a2 + kstep; const char* b3 = b2 + kstep;
            unsigned s0[2], s1[2];
#pragma unroll
            for (int i = 0; i < 2; ++i) { s0[i] = (Sched::GATHER && last) ? vN[0][i] : vA[0][i]; s1[i] = (Sched::GATHER && last) ? vN[1][i] : vA[1][i]; }
            PG8_LDB(B0, 0, 0); PG8_LDB(B1, 0, 1); PG8_SCHED; PG8_LDA(At, 0, 0); PG8_STAGE(PG8_SA(1, 1), a1, vA[1]);
            PG8_WAIT_V(8); PG8_WAIT_L(0); PG8_BAR; PG8_MMA(0, 0, At, B0); PG8_MMA(0, 1, At, B1); PG8_BAR; PG8_SCHED;
            PG8_LDA(At, 0, 1); PG8_STAGE(PG8_SB(0, 0), b2, voffB); PG8_STAGE(PG8_SB(0, 1), b2 + hstep, voffB); PG8_STAGE(PG8_SA(0, 0), a2, s0);
            PG8_WAIT_V(8); PG8_WAIT_L(0); PG8_BAR; PG8_MMA(1, 0, At, B0); PG8_MMA(1, 1, At, B1); PG8_BAR; PG8_SCHED;
            PG8_LDB(B0, 1, 0); PG8_LDB(B1, 1, 1); PG8_SCHED; PG8_LDA(At, 1, 0); PG8_STAGE(PG8_SA(0, 1), a2, s1);
            PG8_WAIT_V(8); PG8_WAIT_L(0); PG8_BAR; PG8_MMA(0, 0, At, B0); PG8_MMA(0, 1, At, B1); PG8_BAR; PG8_SCHED;
            PG8_LDA(At, 1, 1); PG8_STAGE(PG8_SB(1, 0), b3, voffB); PG8_STAGE(PG8_SB(1, 1), b3 + hstep, voffB); PG8_STAGE(PG8_SA(1, 0), a3, s0);
            PG8_WAIT_V(8); PG8_WAIT_L(0); PG8_BAR; PG8_MMA(1, 0, At, B0); PG8_MMA(1, 1, At, B1); PG8_BAR; PG8_SCHED;
        }
        if constexpr (ALIGN_EPI) { if (wr == 0) PG8_BAR; }
        if constexpr (FP8) asm volatile("s_nop 15\n\ts_nop 15" ::: "memory");
        if constexpr (MODE == 2) {
#pragma unroll
            for (int a = 0; a < 2; ++a)
#pragma unroll
                for (int b = 0; b < 2; ++b)
#pragma unroll
                    for (int m = 0; m < 4; ++m)
#pragma unroll
                        for (int n = 0; n < 2; ++n) acc[a][b][m][n] = __builtin_convertvector(__builtin_bit_cast(v4i_t, acc[a][b][m][n]), f32x4); }
        { int t3_ = threadIdx.x; asm volatile("" : "+v"(t3_)); const int fr_ = t3_ & 15, fq_ = (t3_ & 63) >> 4;
          E(acc, cur, S, wr, wc, fr_, fq_, lds, (const LAS unsigned*)(lds + L_RS + (ui & 1) * RS_PAR)); }
        if (!has_next) break;
#pragma unroll
        for (int a = 0; a < 2; ++a)
#pragma unroll
            for (int b = 0; b < 2; ++b)
#pragma unroll
                for (int m = 0; m < 4; ++m)
#pragma unroll
                    for (int n = 0; n < 2; ++n) acc[a][b][m][n] = (f32x4){0.f, 0.f, 0.f, 0.f};
        cur = nxt; cA = nA; cB = nB; ++ui;
        if constexpr (Sched::GATHER) {
#pragma unroll
            for (int h = 0; h < 2; ++h)
#pragma unroll
                for (int i = 0; i < 2; ++i) vA[h][i] = vN[h][i];
        }
        if constexpr (ALIGN_EPI) { if (wr == 1) PG8_BAR; }
    }
    PG8_WAIT_V(0);
    if constexpr (!ALIGN_EPI) { if (wr == 0) PG8_BAR; }
    PG8_BAR;
#undef PG8_SA
#undef PG8_SB
#undef PG8_STAGE
#undef PG8_LDA
#undef PG8_LDB
#undef PG8_MMA
#undef PG8_LD16
#undef PG8_LD16B
#undef PG8_WAIT_V
#undef PG8_WAIT_L
#undef PG8_BAR
#undef PG8_SCHED
#undef PG8_SETV
}

#ifndef NT_EPI
#define NT_EPI 0
#endif
#if NT_EPI
#define NT_ST16(p, v) __builtin_nontemporal_store((v), (u32x4*)(p))
#else
#define NT_ST16(p, v) (*(u32x4*)(p) = (v))
#endif
__device__ __forceinline__ u32x4 pack8(const f32x4& v0, const f32x4& v1) { u32x4 w; w.x = cvt_pk_bf16(v0[0], v0[1]); w.y = cvt_pk_bf16(v0[2], v0[3]); w.z = cvt_pk_bf16(v1[0], v1[1]); w.w = cvt_pk_bf16(v1[2], v1[3]); return w; }

struct EpiNone { static constexpr bool HAS_RS = false; template <class Sched> __device__ __forceinline__ void pf0(const Unit&, const Sched&, int, LAS unsigned*) const {}
    template <class Sched> __device__ __forceinline__ void operator()(const f32x4 (&)[2][2][4][2], const Unit&, const Sched&, int, int, int, int, LAS unsigned char*, const LAS unsigned*) const {} };
template <bool NOSS = false> struct EpiQKV0T {
    bf16* Q; bf16* Kb; bf16* Vb; const u64* ss; float qscale;
    static constexpr bool HAS_RS = !NOSS;
    template <class Sched> __device__ __forceinline__ void pf0(const Unit& u, const Sched&, int tid, LAS unsigned* l) const { const unsigned* p = (const unsigned*)(ss + u.pm * 256 + tid); dma4(p, l); dma4(p + 1, l + 256); }
    template <class Sched> __device__ __forceinline__ void operator()(const f32x4 (&acc)[2][2][4][2], const Unit& u, const Sched&, int wr, int wc, int fr, int fq, LAS unsigned char*, const LAS unsigned* RS) const {
        const int sect = u.pn >> 2, colt = (u.pn & 3) * 256 + wc * 32 + 8 * fq;
#pragma unroll
        for (int ai = 0; ai < 2; ++ai)
#pragma unroll
            for (int m = 0; m < 4; ++m) {
                const int row = u.pm * 256 + ai * 128 + wr * 64 + m * 16 + fr;
                float rs = NOSS ? 1.f : rs_from_planes(RS, ai * 128 + wr * 64 + m * 16 + fr); if (sect == 0) rs *= qscale;
                bf16* dst = (sect == 0) ? Q + (size_t)row * DM : ((sect == 1) ? Kb : Vb) + ((size_t)(row >> 11) * KROWS + 64 + (row & 2047)) * DM;
#pragma unroll
                for (int bj = 0; bj < 2; ++bj) *(u32x4*)(dst + colt + bj * HALF) = pack8(acc[ai][bj][m][0] * rs, acc[ai][bj][m][1] * rs);
            }
    }
};
typedef EpiQKV0T<false> EpiQKV0;
struct EpiQKV0I8 {
    bf16* Q; bf16* Kb; bf16* Vb; const float* ra; const unsigned* cmax; float qscale;
    static constexpr bool HAS_RS = true;
    template <class Sched> __device__ __forceinline__ void pf0(const Unit& u, const Sched&, int tid, LAS unsigned* l) const { dma4(ra + u.pm * 256 + tid, l); }
    template <class Sched> __device__ __forceinline__ void operator()(const f32x4 (&acc)[2][2][4][2], const Unit& u, const Sched&, int wr, int wc, int fr, int fq, LAS unsigned char*, const LAS unsigned* RS) const {
        const int sect = u.pn >> 2, colt = (u.pn & 3) * 256 + wc * 32 + 8 * fq;
        const unsigned* cm = cmax + u.pn * 256 + wc * 32 + 8 * fq; const float cs = (sect == 0 ? qscale : 1.f) * (1.f / 127.f);
        f32x4 sb[2][2];
#pragma unroll
        for (int bj = 0; bj < 2; ++bj)
#pragma unroll
            for (int n = 0; n < 2; ++n) sb[bj][n] = __builtin_bit_cast(f32x4, *(const u32x4*)(cm + bj * 128 + 4 * n)) * cs;
#pragma unroll
        for (int ai = 0; ai < 2; ++ai)
#pragma unroll
            for (int m = 0; m < 4; ++m) {
                const int lrow = ai * 128 + wr * 64 + m * 16 + fr, row = u.pm * 256 + lrow;
                const float rs = __builtin_bit_cast(float, RS[lrow]);
                bf16* dst = (sect == 0) ? Q + (size_t)row * DM : ((sect == 1) ? Kb : Vb) + ((size_t)(row >> 11) * KROWS + 64 + (row & 2047)) * DM;
#pragma unroll
                for (int bj = 0; bj < 2; ++bj) NT_ST16(dst + colt + bj * HALF, pack8(acc[ai][bj][m][0] * (sb[bj][0] * rs), acc[ai][bj][m][1] * (sb[bj][1] * rs)));
            }
    }
};
template <int QM = 0, bool DS = false> struct EpiResidT {
    bf16* h; u64* ss; unsigned char* h8; bf16* hout; const u64* ssp = nullptr; float dsc = 1.f;
    static constexpr bool HAS_RS = (QM == 2);
    template <class Sched> __device__ __forceinline__ void pf0(const Unit& u, const Sched&, int tid, LAS unsigned* l) const { if constexpr (QM == 2) { const unsigned* p = (const unsigned*)(ssp + u.pm * 256 + tid); dma4(p, l); dma4(p + 1, l + 256); } }
    template <class Sched> __device__ __forceinline__ void operator()(const f32x4 (&acc)[2][2][4][2], const Unit& u, const Sched&, int wr, int wc, int fr, int fq, LAS unsigned char*, const LAS unsigned* RS) const {
        const int col = u.pn * 256 + wc * 32 + 8 * fq;
#pragma unroll
        for (int ai = 0; ai < 2; ++ai) {
            u32x4 hv[4][2];
#pragma unroll
            for (int m = 0; m < 4; ++m)
#pragma unroll
                for (int bj = 0; bj < 2; ++bj) hv[m][bj] = *(const u32x4*)(h + (size_t)(u.pm * 256 + ai * 128 + wr * 64 + m * 16 + fr) * DM + col + bj * HALF);
            float sq[4];
#pragma unroll
            for (int m = 0; m < 4; ++m) {
                const int row = u.pm * 256 + ai * 128 + wr * 64 + m * 16 + fr; float s = 0.f;
                float qi = 0.f; if constexpr (QM == 2) qi = frsq(ms_from_planes(RS, ai * 128 + wr * 64 + m * 16 + fr)) * (127.f / CQ);
#pragma unroll
                for (int bj = 0; bj < 2; ++bj) {
                    const u32x4 o = hv[m][bj];
                    f32x4 v0 = acc[ai][bj][m][0], v1 = acc[ai][bj][m][1]; if constexpr (DS) { v0 = v0 * dsc; v1 = v1 * dsc; }
                    v0[0] += bflo(o.x); v0[1] += bfhi(o.x); v0[2] += bflo(o.y); v0[3] += bfhi(o.y); v1[0] += bflo(o.z); v1[1] += bfhi(o.z); v1[2] += bflo(o.w); v1[3] += bfhi(o.w);
                    s += (v0[0] * v0[0] + v0[1] * v0[1]) + (v0[2] * v0[2] + v0[3] * v0[3]) + (v1[0] * v1[0] + v1[1] * v1[1]) + (v1[2] * v1[2] + v1[3] * v1[3]);
                    *(u32x4*)(hout + (size_t)row * DM + col + bj * HALF) = pack8(v0, v1);
                    if constexpr (QM == 1) { u32x2 q; q.x = pk4_fp8(v0[0] * QS_H, v0[1] * QS_H, v0[2] * QS_H, v0[3] * QS_H); q.y = pk4_fp8(v1[0] * QS_H, v1[1] * QS_H, v1[2] * QS_H, v1[3] * QS_H); *(u32x2*)(h8 + (size_t)row * DM + col + bj * HALF) = q; }
                    if constexpr (QM == 2) { u32x2 q; q.x = pk4_i8(v0[0] * qi, v0[1] * qi, v0[2] * qi, v0[3] * qi); q.y = pk4_i8(v1[0] * qi, v1[1] * qi, v1[2] * qi, v1[3] * qi); *(u32x2*)(h8 + (size_t)row * DM + col + bj * HALF) = q; }
                }
                s += __shfl_xor(s, 16); s += __shfl_xor(s, 32); sq[m] = s;
            }
            const float val = fq == 0 ? sq[0] : fq == 1 ? sq[1] : fq == 2 ? sq[2] : sq[3];
            atomicAdd(ss + u.pm * 256 + ai * 128 + wr * 64 + fq * 16 + fr, to_fx(val));
        }
    }
};
typedef EpiResidT<0> EpiResid;
template <bool MOE> struct EpiSwiglu {
    bf16* act; const u64* ss;
    static constexpr bool HAS_RS = true;
    template <class Sched> __device__ __forceinline__ void pf0(const Unit& u, const Sched& S, int tid, LAS unsigned* l) const {
        const int srow = MOE ? S.a_row(u, tid) : u.pm * 256 + tid; const unsigned* p = (const unsigned*)(ss + srow); dma4(p, l); dma4(p + 1, l + 256); }
    template <class Sched> __device__ __forceinline__ void operator()(const f32x4 (&acc)[2][2][4][2], const Unit& u, const Sched& S, int wr, int wc, int fr, int fq, LAS unsigned char*, const LAS unsigned* RS) const {
        const int col = u.pn * 128 + wc * 32 + 8 * fq;
#pragma unroll
        for (int ai = 0; ai < 2; ++ai)
#pragma unroll
            for (int m = 0; m < 4; ++m) {
                const int lrow = ai * 128 + wr * 64 + m * 16 + fr, orow = u.pm * 256 + lrow;
                const float rs = rs_from_planes(RS, lrow);
                const float rq = MOE ? rs * (1.f / (QS_H * QS_WGU)) : rs; const float c1 = -rq * LOG2E, k2 = frcp(rq * rq * (MOE ? QS_ACT : 1.f));
                f32x4 o[2];
#pragma unroll
                for (int n = 0; n < 2; ++n)
#pragma unroll
                    for (int i = 0; i < 4; i += 2) { const f32x2 g = {acc[ai][0][m][n][i], acc[ai][0][m][n][i + 1]}, uu = {acc[ai][1][m][n][i], acc[ai][1][m][n][i + 1]};
                        const f32x2 a = g * c1; f32x2 e; e.x = fexp2(a.x); e.y = fexp2(a.y); f32x2 r; r.x = frcp(__builtin_fmaf(e.x, k2, k2)); r.y = frcp(__builtin_fmaf(e.y, k2, k2));
                        f32x2 v = (g * uu) * r; if constexpr (MOE) { v.x = clamp8(v.x); v.y = clamp8(v.y); } o[n][i] = v.x; o[n][i + 1] = v.y; }
                if constexpr (MOE) { u32x2 q; int p0 = __builtin_amdgcn_cvt_pk_fp8_f32(o[0][0], o[0][1], 0, false); p0 = __builtin_amdgcn_cvt_pk_fp8_f32(o[0][2], o[0][3], p0, true);
                    int p1 = __builtin_amdgcn_cvt_pk_fp8_f32(o[1][0], o[1][1], 0, false); p1 = __builtin_amdgcn_cvt_pk_fp8_f32(o[1][2], o[1][3], p1, true); q.x = (unsigned)p0; q.y = (unsigned)p1;
                    *(u32x2*)((unsigned char*)act + (size_t)orow * FF + col) = q; }
                else *(u32x4*)(act + (size_t)orow * FF + col) = pack8(o[0], o[1]);
            }
    }
};
template <bool F8OUT> struct EpiSwigluI8T {
    bf16* act; const u64* ss; const u64* ssp; const unsigned* cmax;
    static constexpr bool HAS_RS = true;
    template <class Sched> __device__ __forceinline__ void pf0(const Unit& u, const Sched&, int tid, LAS unsigned* l) const {
        const unsigned* p = (const unsigned*)(ss + u.pm * 256 + tid); dma4(p, l); dma4(p + 1, l + 256); const unsigned* p2 = (const unsigned*)(ssp + u.pm * 256 + tid); dma4(p2, l + 512); dma4(p2 + 1, l + 768); }
    template <class Sched> __device__ __forceinline__ void operator()(const f32x4 (&acc)[2][2][4][2], const Unit& u, const Sched&, int wr, int wc, int fr, int fq, LAS unsigned char*, const LAS unsigned* RS) const {
        const int col = u.pn * 128 + wc * 32 + 8 * fq;
        const unsigned* cm = cmax + u.pn * 256 + wc * 32 + 8 * fq;
        f32x4 sg[2], su[2];
#pragma unroll
        for (int n = 0; n < 2; ++n) { const u32x4 a = *(const u32x4*)(cm + 4 * n), b = *(const u32x4*)(cm + 128 + 4 * n);
            sg[n] = __builtin_bit_cast(f32x4, a) * (1.f / 127.f); su[n] = __builtin_bit_cast(f32x4, b) * (1.f / 127.f); }
#pragma unroll
        for (int ai = 0; ai < 2; ++ai)
#pragma unroll
            for (int m = 0; m < 4; ++m) {
                const int lrow = ai * 128 + wr * 64 + m * 16 + fr, orow = u.pm * 256 + lrow;
                const float rs = rs_from_planes(RS, lrow), msp = ms_from_planes(RS + 512, lrow);
                const float rq = rs * (msp * frsq(msp)) * (CQ / 127.f); const float c1 = -rq * LOG2E, k2 = frcp(rq * rq * (F8OUT ? QS_ACT : 1.f));
                f32x4 o[2];
#pragma unroll
                for (int n = 0; n < 2; ++n)
#pragma unroll
                    for (int i = 0; i < 4; i += 2) {
                        f32x2 g = {acc[ai][0][m][n][i], acc[ai][0][m][n][i + 1]}, uu = {acc[ai][1][m][n][i], acc[ai][1][m][n][i + 1]};
                        g = g * (f32x2){sg[n][i], sg[n][i + 1]}; uu = uu * (f32x2){su[n][i], su[n][i + 1]};
                        const f32x2 a = g * c1; f32x2 e; e.x = fexp2(a.x); e.y = fexp2(a.y); f32x2 r; r.x = frcp(__builtin_fmaf(e.x, k2, k2)); r.y = frcp(__builtin_fmaf(e.y, k2, k2));
                        f32x2 v = (g * uu) * r; o[n][i] = v.x; o[n][i + 1] = v.y; }
                if constexpr (F8OUT) { u32x2 q; q.x = pk4_fp8(o[0][0], o[0][1], o[0][2], o[0][3]); q.y = pk4_fp8(o[1][0], o[1][1], o[1][2], o[1][3]); *(u32x2*)((unsigned char*)act + (size_t)orow * FF + col) = q; }
                else *(u32x4*)(act + (size_t)orow * FF + col) = pack8(o[0], o[1]);
            }
    }
};
typedef EpiSwigluI8T<false> EpiSwigluI8;
template <bool I8> struct EpiHeadNormT {
    bf16* Q; bf16* Kb; bf16* Vb; const u64* ss; const float* qn; const float* kn; float descale; const u64* ssp = nullptr; const unsigned* cmax = nullptr;
    static constexpr bool HAS_RS = true;
    template <class Sched> __device__ __forceinline__ void pf0(const Unit& u, const Sched&, int tid, LAS unsigned* l) const { const unsigned* p = (const unsigned*)(ss + u.pm * 256 + tid); dma4(p, l); dma4(p + 1, l + 256);
        if constexpr (I8) { const unsigned* p2 = (const unsigned*)(ssp + u.pm * 256 + tid); dma4(p2, l + 512); dma4(p2 + 1, l + 768); } }
    template <class Sched> __device__ __forceinline__ void operator()(const f32x4 (&accr)[2][2][4][2], const Unit& u, const Sched&, int wr, int wc, int fr, int fq, LAS unsigned char* lds, const LAS unsigned* RS) const {
        const int sect = u.pn >> 2, colt = (u.pn & 3) * 256 + wc * 32 + 8 * fq;
        f32x4 sb[2][2];
        if constexpr (I8) { const unsigned* cm = cmax + u.pn * 256 + wc * 32 + 8 * fq;
#pragma unroll
            for (int bj = 0; bj < 2; ++bj)
#pragma unroll
                for (int n = 0; n < 2; ++n) sb[bj][n] = __builtin_bit_cast(f32x4, *(const u32x4*)(cm + bj * 128 + 4 * n)) * (1.f / 127.f); }
        float rs[2][4];
#pragma unroll
        for (int ai = 0; ai < 2; ++ai)
#pragma unroll
            for (int m = 0; m < 4; ++m) { const int lr = ai * 128 + wr * 64 + m * 16 + fr;
                if constexpr (I8) { const float msp = ms_from_planes(RS + 512, lr); rs[ai][m] = rs_from_planes(RS, lr) * (msp * frsq(msp)) * (CQ / 127.f); } else rs[ai][m] = rs_from_planes(RS, lr) * descale; }
        if (sect == 2) {
#pragma unroll
            for (int ai = 0; ai < 2; ++ai)
#pragma unroll
                for (int m = 0; m < 4; ++m) { const int row = u.pm * 256 + ai * 128 + wr * 64 + m * 16 + fr; bf16* dst = Vb + ((size_t)(row >> 11) * KROWS + 64 + (row & 2047)) * DM;
#pragma unroll
                    for (int bj = 0; bj < 2; ++bj) NT_ST16(dst + colt + bj * HALF, pack8(accr[ai][bj][m][0] * (I8 ? sb[bj][0] * rs[ai][m] : (f32x4){rs[ai][m], rs[ai][m], rs[ai][m], rs[ai][m]}), accr[ai][bj][m][1] * (I8 ? sb[bj][1] * rs[ai][m] : (f32x4){rs[ai][m], rs[ai][m], rs[ai][m], rs[ai][m]}))); }
            return;
        }
        LAS float* X = (LAS float*)(lds + L_X);
        float part[2][2][4];
#pragma unroll
        for (int ai = 0; ai < 2; ++ai)
#pragma unroll
            for (int bj = 0; bj < 2; ++bj)
#pragma unroll
                for (int m = 0; m < 4; ++m) { f32x4 v0, v1; if constexpr (I8) { v0 = accr[ai][bj][m][0] * (sb[bj][0] * rs[ai][m]); v1 = accr[ai][bj][m][1] * (sb[bj][1] * rs[ai][m]); } else { v0 = accr[ai][bj][m][0] * rs[ai][m]; v1 = accr[ai][bj][m][1] * rs[ai][m]; }
                    float s = (v0[0] * v0[0] + v0[1] * v0[1]) + (v0[2] * v0[2] + v0[3] * v0[3]) + (v1[0] * v1[0] + v1[1] * v1[1]) + (v1[2] * v1[2] + v1[3] * v1[3]);
                    s += __shfl_xor(s, 16); s += __shfl_xor(s, 32); part[ai][bj][m] = s;
                    if (fq == 0) X[((ai * 128 + wr * 64 + m * 16 + fr) * 2 + bj) * 4 + wc] = s; }
        asm volatile("s_waitcnt lgkmcnt(0)\n\ts_barrier" ::: "memory");
        const float* gp = (sect == 0 ? qn : kn) + (wc & 1) * 32 + 8 * fq; const float gsc = sect == 0 ? C2 : 1.f;
        f32x4 g0 = *(const f32x4*)gp * gsc, g1 = *(const f32x4*)(gp + 4) * gsc;
#pragma unroll
        for (int ai = 0; ai < 2; ++ai)
#pragma unroll
            for (int m = 0; m < 4; ++m) { const int row = u.pm * 256 + ai * 128 + wr * 64 + m * 16 + fr;
                bf16* dst = (sect == 0) ? Q + (size_t)row * DM : Kb + ((size_t)(row >> 11) * KROWS + 64 + (row & 2047)) * DM;
#pragma unroll
                for (int bj = 0; bj < 2; ++bj) { const float tot = part[ai][bj][m] + X[((ai * 128 + wr * 64 + m * 16 + fr) * 2 + bj) * 4 + (wc ^ 1)];
                    const float hs = frsq(tot * (1.f / HD) + EPS) * rs[ai][m];
                    if constexpr (I8) NT_ST16(dst + colt + bj * HALF, pack8(accr[ai][bj][m][0] * (hs * (sb[bj][0] * g0)), accr[ai][bj][m][1] * (hs * (sb[bj][1] * g1))));
                    else *(u32x4*)(dst + colt + bj * HALF) = pack8(accr[ai][bj][m][0] * hs * g0, accr[ai][bj][m][1] * hs * g1); } }
    }
};
typedef EpiHeadNormT<false> EpiHeadNorm;
struct EpiMoE2 {
    bf16* C;
    static constexpr bool HAS_RS = true;
    template <class Sched> __device__ __forceinline__ void pf0(const Unit& u, const Sched& S, int tid, LAS unsigned* l) const { dma4(S.gate_ptr(u, tid), l); }
    template <class Sched> __device__ __forceinline__ void operator()(const f32x4 (&acc)[2][2][4][2], const Unit& u, const Sched& S, int wr, int wc, int fr, int fq, LAS unsigned char*, const LAS unsigned* RS) const {
        const int col = u.pn * 256 + wc * 32 + 8 * fq;
#pragma unroll
        for (int ai = 0; ai < 2; ++ai)
#pragma unroll
            for (int m = 0; m < 4; ++m) { const int lrow = ai * 128 + wr * 64 + m * 16 + fr; const float gt = __builtin_bit_cast(float, RS[lrow]) * (1.f / (QS_ACT * QS_WDN)); bf16* dst = C + (size_t)(u.pm * 256 + lrow) * DM + col;
#pragma unroll
                for (int bj = 0; bj < 2; ++bj) *(u32x4*)(dst + bj * HALF) = pack8(acc[ai][bj][m][0] * gt, acc[ai][bj][m][1] * gt); }
    }
};
}
namespace att {
constexpr int A_K = 0, A_V = 16384, A_WS = 32768, A_OST = 34816, A_NB = 67584, A_FLAG = 76288, A_SCAN = 76416, A_END = 76544;
static_assert(A_NB + KROWS * 4 <= A_FLAG && A_END <= RING_BYTES, "attention lds map");
__device__ __forceinline__ int crow(int r, int hi) { return (r & 3) + 8 * (r >> 2) + 4 * hi; }
__device__ __forceinline__ void glds16(const void* gsrc, unsigned lds_dst) { unsigned keep;
    asm volatile("s_mov_b32 %0, m0\n\ts_mov_b32 m0, %2\n\ts_nop 0\n\tglobal_load_lds_dwordx4 %1, off\n\ts_mov_b32 m0, %0" : "=&s"(keep) : "v"(gsrc), "s"(lds_dst) : "memory"); }
#define ATT_WAIT_BAR(N) asm volatile("s_waitcnt vmcnt(" #N ") lgkmcnt(0)\n\ts_barrier" ::: "memory")
__device__ __forceinline__ void qkt(f32x16& p0, f32x16& p1, const LAS unsigned char* Kslot, const bf16x8* qr, const f32x16& cinit, int r32, int hi) {
    const LAS unsigned char* kb = Kslot + hi * 1024 + r32 * 16;
#pragma unroll
    for (int d0 = 0; d0 < 4; ++d0) {
        const bf16x8 b0 = *(const LAS bf16x8*)(kb + d0 * 2048);
        const bf16x8 b1 = *(const LAS bf16x8*)(kb + d0 * 2048 + 512);
        if (d0 == 0) { p0 = __builtin_amdgcn_mfma_f32_32x32x16_bf16(b0, qr[0], cinit, 0, 0, 0); p1 = __builtin_amdgcn_mfma_f32_32x32x16_bf16(b1, qr[0], cinit, 0, 0, 0); }
        else { p0 = __builtin_amdgcn_mfma_f32_32x32x16_bf16(b0, qr[d0], p0, 0, 0, 0); p1 = __builtin_amdgcn_mfma_f32_32x32x16_bf16(b1, qr[d0], p1, 0, 0, 0); } }
}
__device__ __forceinline__ void pv(f32x16* o, int vb, bf16x8 pa0, bf16x8 pa1, bf16x8 pa2, bf16x8 pa3) {
#pragma unroll
    for (int d0 = 0; d0 < 2; ++d0) { s16x4 lo[4], hi[4];
#pragma unroll
        for (int ks = 0; ks < 4; ++ks) {
            asm volatile("ds_read_b64_tr_b16 %0,%1 offset:%c2" : "=&v"(lo[ks]) : "v"(vb), "i"(d0 * 4096 + ks * 1024) : "memory");
            asm volatile("ds_read_b64_tr_b16 %0,%1 offset:%c2" : "=&v"(hi[ks]) : "v"(vb), "i"(d0 * 4096 + ks * 1024 + 512) : "memory"); }
        asm volatile("s_waitcnt lgkmcnt(0)" ::: "memory"); __builtin_amdgcn_sched_barrier(0);
#define ATT_PK(k) (bf16x8){lo[k][0], lo[k][1], lo[k][2], lo[k][3], hi[k][0], hi[k][1], hi[k][2], hi[k][3]}
        o[d0] = __builtin_amdgcn_mfma_f32_32x32x16_bf16(pa0, ATT_PK(0), o[d0], 0, 0, 0);
        o[d0] = __builtin_amdgcn_mfma_f32_32x32x16_bf16(pa1, ATT_PK(1), o[d0], 0, 0, 0);
        o[d0] = __builtin_amdgcn_mfma_f32_32x32x16_bf16(pa2, ATT_PK(2), o[d0], 0, 0, 0);
        o[d0] = __builtin_amdgcn_mfma_f32_32x32x16_bf16(pa3, ATT_PK(3), o[d0], 0, 0, 0);
#undef ATT_PK
    }
}
__device__ __forceinline__ float swap_lo(float v, float& other_hi) { auto rr = __builtin_amdgcn_permlane32_swap(__float_as_uint(v), __float_as_uint(v), false, false); other_hi = __uint_as_float(rr[1]); return __uint_as_float(rr[0]); }

template <int MODE>
__device__ __forceinline__ void attn_unit(int b, int h, int qb, const bf16* Q, const bf16* __restrict__ K, const bf16* __restrict__ V, bf16* O, LAS unsigned char* shm) {
    int tid_ = threadIdx.x; asm volatile("" : "+v"(tid_));
    const int tid = tid_, lane = tid & 63, r32 = lane & 31, hi = lane >> 5; const int wid = __builtin_amdgcn_readfirstlane(tid >> 6);
    const bf16* Qw = Q + ((size_t)b * SEQ + qb * 256 + wid * 32) * DM + h * HD;
    const bf16* Kh = K + (size_t)b * KROWS * DM + h * HD; const bf16* Vh = V + (size_t)b * KROWS * DM + h * HD;
    const unsigned lds0 = (unsigned)(uintptr_t)shm;
    LAS float* wsf = (LAS float*)(shm + A_WS) + wid * 64;
    const bf16* ksrc = Kh + (size_t)lane * DM + wid * 8;
    const bf16* vsrc = Vh + (size_t)(16 * (wid & 3) + (lane >> 2)) * DM + (wid >> 2) * 32 + (lane & 3) * 8;
    const unsigned kdst = lds0 + A_K + wid * 1024, vdst = lds0 + A_V + wid * 1024;
#define ATT_DMA_K(t, slot) glds16(ksrc + (size_t)(t) * 64 * DM, (unsigned)__builtin_amdgcn_readfirstlane(kdst + (slot)))
#define ATT_DMA_V(t, slot) glds16(vsrc + (size_t)(t) * 64 * DM, (unsigned)__builtin_amdgcn_readfirstlane(vdst + (slot)))
    const int vb0 = (int)(lds0 + A_V) + ((lane >> 4) & 1) * 32 + (lane & 3) * 8 + (4 * hi + ((lane & 15) >> 2)) * 64;
    const int jmax = 4 * qb + 4;
    const int qrel = wid * 32 + r32;
    const int j0 = (MODE == 0) ? jmax : 0;
    ATT_DMA_K(j0, (j0 & 1) * 8192); ATT_DMA_V(j0, (j0 & 1) * 8192);
    bf16x8 qr[4];
#pragma unroll
    for (int d0 = 0; d0 < 4; ++d0) qr[d0] = *(const bf16x8*)(Qw + (size_t)r32 * DM + d0 * 16 + hi * 8);
    f32x16 o[2]; o[0] = f32x16{}; o[1] = f32x16{};
    float Cc = 1.f;
    float mrow = -1e30f, lsum = 0.f;
    f32x16 cin = f32x16{};
    if (MODE == 1) { const float ft = -((const LAS float*)(shm + A_NB))[64 + qb * 256 + qrel];
#pragma unroll
        for (int r = 0; r < 16; ++r) cin[r] = ft; }
    bool done = false;
    LAS unsigned* flags = (LAS unsigned*)(shm + A_FLAG);
    for (int jj = 0; jj <= jmax; ++jj) {
        const int j = (MODE == 0) ? jmax - jj : jj;
        const int s = (j & 1) * 8192;
        ATT_WAIT_BAR(0);
        if (MODE == 0 && jj > 0) { const LAS u32x4* fp = (const LAS u32x4*)(flags + ((jj + 1) & 1) * 8); const u32x4 fa = fp[0], fb = fp[1];
            if ((fa.x & fa.y & fa.z & fa.w & fb.x & fb.y & fb.z & fb.w) != 0u) break; }
        if (jj < jmax) { const int jn = (MODE == 0) ? j - 1 : j + 1; ATT_DMA_K(jn, (jn & 1) * 8192); ATT_DMA_V(jn, (jn & 1) * 8192); }
        const int jb = j - (4 * qb + 1);
        const bool active = !done && (64 * jb <= wid * 32 + 31 - (MODE == 0 ? 1 : 0));
        if (active) {
            f32x16 p0, p1;
            qkt(p0, p1, shm + A_K + s, qr, cin, r32, hi);
            if (MODE == 0) {
                float A0[16], A1[16], G[8];
#pragma unroll
                for (int g = 0; g < 4; ++g) {
                    float w0[4], w1[4], b0[4], b1[4];
#pragma unroll
                    for (int i = 0; i < 4; ++i) { const int r = 4 * g + i;
                        const float e0 = fexp2(fminf(p0[r], 80.f)), e1 = fexp2(fminf(p1[r], 80.f));
                        b0[i] = frcp(1.f + e0); b1[i] = frcp(1.f + e1); w0[i] = e0 * b0[i]; w1[i] = e1 * b1[i]; }
                    if (jb >= 0 || j == 0) {
#pragma unroll
                        for (int i = 0; i < 4; ++i) { const int k0 = crow(4 * g + i, hi), k1 = k0 + 32;
                            const bool v0 = (j == 0) ? (k0 >= 48) : (64 * jb + k0 < qrel), v1 = (j == 0) ? (k1 >= 48) : (64 * jb + k1 < qrel);
                            b0[i] = v0 ? b0[i] : 0.f; w0[i] = v0 ? w0[i] : 1.f; b1[i] = v1 ? b1[i] : 0.f; w1[i] = v1 ? w1[i] : 1.f; }
                    }
                    { const float t2 = w0[3], t1 = t2 * w0[2], t0 = t1 * w0[1]; G[g] = t0 * w0[0]; A0[4 * g + 3] = b0[3]; A0[4 * g + 2] = b0[2] * t2; A0[4 * g + 1] = b0[1] * t1; A0[4 * g] = b0[0] * t0; }
                    { const float t2 = w1[3], t1 = t2 * w1[2], t0 = t1 * w1[1]; G[4 + g] = t0 * w1[0]; A1[4 * g + 3] = b1[3]; A1[4 * g + 2] = b1[2] * t2; A1[4 * g + 1] = b1[1] * t1; A1[4 * g] = b1[0] * t0; }
                }
                float GG[16];
#pragma unroll
                for (int g = 0; g < 8; ++g) { float oh; const float ol = swap_lo(G[g], oh); GG[2 * g] = ol; GG[2 * g + 1] = oh; }
                float Tx[16]; Tx[15] = Cc;
#pragma unroll
                for (int x = 14; x >= 0; --x) Tx[x] = Tx[x + 1] * GG[x + 1];
                Cc = Tx[0] * GG[0];
#pragma unroll
                for (int g = 0; g < 4; ++g) { const float t0 = hi ? Tx[2 * g + 1] : Tx[2 * g], t1 = hi ? Tx[8 + 2 * g + 1] : Tx[8 + 2 * g];
#pragma unroll
                    for (int i = 0; i < 4; ++i) { p0[4 * g + i] = A0[4 * g + i] * t0; p1[4 * g + i] = A1[4 * g + i] * t1; } }
                done = __all(Cc == 0.f);
            } else {
                const LAS f32x4* nbp = (const LAS f32x4*)(shm + A_NB) + 16 * j + hi;
#pragma unroll
                for (int g = 0; g < 4; ++g) { const f32x4 n0 = nbp[2 * g], n1 = nbp[2 * g + 8];
#pragma unroll
                    for (int i = 0; i < 4; ++i) { p0[4 * g + i] += n0[i]; p1[4 * g + i] += n1[i]; } }
                if (jb >= 0) {
#pragma unroll
                    for (int r = 0; r < 16; ++r) { const int k0 = 64 * jb + crow(r, hi); if (k0 > qrel) p0[r] = -INFINITY; if (k0 + 32 > qrel) p1[r] = -INFINITY; }
                }
                float rm = fmaxf(p0[0], p1[0]);
#pragma unroll
                for (int r = 1; r < 16; ++r) rm = fmaxf(rm, fmaxf(p0[r], p1[r]));
                { float oh; const float ol = swap_lo(rm, oh); rm = fmaxf(ol, oh); }
                const float mnew = fmaxf(mrow, rm);
                if (__any(mnew > mrow)) {
                    const float f = fexp2(mrow - mnew); lsum *= f; if (hi == 0) wsf[r32] = f; mrow = mnew;
                    LDS_WAIT();
#pragma unroll
                    for (int r = 0; r < 16; ++r) { const float fr_ = wsf[crow(r, hi)]; o[0][r] *= fr_; o[1][r] *= fr_; }
                }
                float sacc = 0.f;
#pragma unroll
                for (int r = 0; r < 16; ++r) { p0[r] = fexp2(p0[r] - mrow); p1[r] = fexp2(p1[r] - mrow); sacc += p0[r] + p1[r]; }
                lsum += sacc;
            }
            u32x4 pw0, pw1, pw2, pw3;
            pw0 = (u32x4){cvtpk_s(p0[0], p0[1]), cvtpk_s(p0[2], p0[3]), cvtpk_s(p0[4], p0[5]), cvtpk_s(p0[6], p0[7])};
            pw1 = (u32x4){cvtpk_s(p0[8], p0[9]), cvtpk_s(p0[10], p0[11]), cvtpk_s(p0[12], p0[13]), cvtpk_s(p0[14], p0[15])};
            pw2 = (u32x4){cvtpk_s(p1[0], p1[1]), cvtpk_s(p1[2], p1[3]), cvtpk_s(p1[4], p1[5]), cvtpk_s(p1[6], p1[7])};
            pw3 = (u32x4){cvtpk_s(p1[8], p1[9]), cvtpk_s(p1[10], p1[11]), cvtpk_s(p1[12], p1[13]), cvtpk_s(p1[14], p1[15])};
            pv(o, vb0 + s, __builtin_bit_cast(bf16x8, pw0), __builtin_bit_cast(bf16x8, pw1), __builtin_bit_cast(bf16x8, pw2), __builtin_bit_cast(bf16x8, pw3));
        }
        if (MODE == 0 && lane == 0) flags[(jj & 1) * 8 + wid] = done ? 1u : 0u;
    }
    float rli[16];
    if (MODE == 1) {
        { float oh; const float ol = swap_lo(lsum, oh); lsum = ol + oh; }
        if (hi == 0) wsf[32 + r32] = lsum; LDS_WAIT();
#pragma unroll
        for (int r = 0; r < 16; ++r) rli[r] = frcp(wsf[32 + crow(r, hi)]);
    } else {
#pragma unroll
        for (int r = 0; r < 16; ++r) rli[r] = 1.f;
    }
    bf16* Ow = O + ((size_t)b * SEQ + qb * 256 + wid * 32) * DM + h * HD;
    { LAS bf16* stg = (LAS bf16*)(shm + A_OST) + wid * 2048;
#pragma unroll
        for (int r = 0; r < 16; ++r) { const int orow = crow(r, hi);
#pragma unroll
            for (int d0 = 0; d0 < 2; ++d0) stg[orow * 64 + d0 * 32 + r32] = (bf16)f2bf(o[d0][r] * rli[r]); }
        LDS_WAIT();
#pragma unroll
        for (int i = 0; i < 4; ++i) { const int row = i * 8 + (lane >> 3), ch = lane & 7; const u32x4 v = *(const LAS u32x4*)(stg + row * 64 + ch * 8); *(u32x4*)(Ow + (size_t)row * DM + ch * 8) = v; } }
    asm volatile("s_waitcnt vmcnt(0) lgkmcnt(0)\n\ts_barrier" ::: "memory");
#undef ATT_DMA_K
#undef ATT_DMA_V
}
__device__ __forceinline__ void sb_unit_wave(int b, int h, int qb, const bf16* Q, const bf16* __restrict__ K, const bf16* __restrict__ V, bf16* O, LAS unsigned char* shm) {
    int tid_ = threadIdx.x; asm volatile("" : "+v"(tid_));
    const int tid = tid_, lane = tid & 63, r32 = lane & 31, hi = lane >> 5; const int wid = __builtin_amdgcn_readfirstlane(tid >> 6);
    const bf16* Qw = Q + ((size_t)b * SEQ + qb * 256 + wid * 32) * DM + h * HD;
    const bf16* Kh = K + (size_t)b * KROWS * DM + h * HD; const bf16* Vh = V + (size_t)b * KROWS * DM + h * HD;
    LAS unsigned char* kslot = shm + wid * 16384; LAS unsigned char* vslot = kslot + 8192;
    const unsigned kdst = (unsigned)(uintptr_t)kslot, vdst = (unsigned)(uintptr_t)vslot;
    const bf16* ksrcE = Kh + (size_t)(lane >> 3) * DM + (((lane & 7) ^ (lane >> 4)) * 8);
    const bf16* ksrcO = Kh + (size_t)(lane >> 3) * DM + (((lane & 7) ^ (lane >> 4) ^ 4) * 8);
    int kaddr[4];
#pragma unroll
    for (int d0 = 0; d0 < 4; ++d0) kaddr[d0] = r32 * 128 + ((((hi ^ ((r32 >> 1) & 7)) ^ (2 * d0)) << 4));
    const bf16* vsrc = Vh + (size_t)(lane >> 2) * DM + (lane & 3) * 8;
#define SB_DMA_K(t) do { _Pragma("unroll") for (int c_ = 0; c_ < 8; ++c_) glds16(((c_ & 1) ? ksrcO : ksrcE) + (size_t)((t) * 64 + 8 * c_) * DM, (unsigned)__builtin_amdgcn_readfirstlane((int)(kdst + c_ * 1024))); } while (0)
#define SB_DMA_V(t) do { _Pragma("unroll") for (int p_ = 0; p_ < 8; ++p_) glds16(vsrc + (size_t)(t) * 64 * DM + (size_t)(16 * (p_ & 3)) * DM + (p_ >> 2) * 32, (unsigned)__builtin_amdgcn_readfirstlane((int)(vdst + p_ * 1024))); } while (0)
    const int vb0 = (int)vdst + ((lane >> 4) & 1) * 32 + (lane & 3) * 8 + (4 * hi + ((lane & 15) >> 2)) * 64;
    const int qrel = wid * 32 + r32;
    const int jhi = 4 * qb + 1 + (wid >> 1);
    SB_DMA_K(jhi); SB_DMA_V(jhi);
    bf16x8 qr[4];
#pragma unroll
    for (int d0 = 0; d0 < 4; ++d0) qr[d0] = *(const bf16x8*)(Qw + (size_t)r32 * DM + d0 * 16 + hi * 8);
    f32x16 o[2]; o[0] = f32x16{}; o[1] = f32x16{};
    float Cc = 1.f; const f32x16 zero16 = f32x16{};
    for (int j = jhi; j >= 0; --j) {
        asm volatile("s_waitcnt vmcnt(8)" ::: "memory");
        f32x16 p0, p1;
#pragma unroll
        for (int d0 = 0; d0 < 4; ++d0) {
            const bf16x8 b0 = *(const LAS bf16x8*)(kslot + kaddr[d0]);
            const bf16x8 b1 = *(const LAS bf16x8*)(kslot + kaddr[d0] + 4096);
            if (d0 == 0) { p0 = __builtin_amdgcn_mfma_f32_32x32x16_bf16(b0, qr[0], zero16, 0, 0, 0); p1 = __builtin_amdgcn_mfma_f32_32x32x16_bf16(b1, qr[0], zero16, 0, 0, 0); }
            else { p0 = __builtin_amdgcn_mfma_f32_32x32x16_bf16(b0, qr[d0], p0, 0, 0, 0); p1 = __builtin_amdgcn_mfma_f32_32x32x16_bf16(b1, qr[d0], p1, 0, 0, 0); } }
        asm volatile("s_waitcnt lgkmcnt(0)" ::: "memory");
        if (j > 0) SB_DMA_K(j - 1);
        const int jb = j - (4 * qb + 1);
        {
            float A0[16], A1[16], G[8];
#pragma unroll
            for (int g = 0; g < 4; ++g) {
                float w0[4], w1[4], b0[4], b1[4];
#pragma unroll
                for (int i = 0; i < 4; ++i) { const int r = 4 * g + i;
                    const float e0 = fexp2(fminf(p0[r], 80.f)), e1 = fexp2(fminf(p1[r], 80.f));
                    b0[i] = frcp(1.f + e0); b1[i] = frcp(1.f + e1); w0[i] = e0 * b0[i]; w1[i] = e1 * b1[i]; }
                if (jb >= 0 || j == 0) {
#pragma unroll
                    for (int i = 0; i < 4; ++i) { const int k0 = crow(4 * g + i, hi), k1 = k0 + 32;
                        const bool v0 = (j == 0) ? (k0 >= 48) : (64 * jb + k0 < qrel), v1 = (j == 0) ? (k1 >= 48) : (64 * jb + k1 < qrel);
                        b0[i] = v0 ? b0[i] : 0.f; w0[i] = v0 ? w0[i] : 1.f; b1[i] = v1 ? b1[i] : 0.f; w1[i] = v1 ? w1[i] : 1.f; }
                }
                { const float t2 = w0[3], t1 = t2 * w0[2], t0 = t1 * w0[1]; G[g] = t0 * w0[0]; A0[4 * g + 3] = b0[3]; A0[4 * g + 2] = b0[2] * t2; A0[4 * g + 1] = b0[1] * t1; A0[4 * g] = b0[0] * t0; }
                { const float t2 = w1[3], t1 = t2 * w1[2], t0 = t1 * w1[1]; G[4 + g] = t0 * w1[0]; A1[4 * g + 3] = b1[3]; A1[4 * g + 2] = b1[2] * t2; A1[4 * g + 1] = b1[1] * t1; A1[4 * g] = b1[0] * t0; }
            }
            float GG[16];
#pragma unroll
            for (int g = 0; g < 8; ++g) { float oh; const float ol = swap_lo(G[g], oh); GG[2 * g] = ol; GG[2 * g + 1] = oh; }
            float Tx[16]; Tx[15] = Cc;
#pragma unroll
            for (int x = 14; x >= 0; --x) Tx[x] = Tx[x + 1] * GG[x + 1];
            Cc = Tx[0] * GG[0];
#pragma unroll
            for (int g = 0; g < 4; ++g) { const float t0 = hi ? Tx[2 * g + 1] : Tx[2 * g], t1 = hi ? Tx[8 + 2 * g + 1] : Tx[8 + 2 * g];
#pragma unroll
                for (int i = 0; i < 4; ++i) { p0[4 * g + i] = A0[4 * g + i] * t0; p1[4 * g + i] = A1[4 * g + i] * t1; } }
        }
        u32x4 pw0, pw1, pw2, pw3;
        pw0 = (u32x4){cvtpk_s(p0[0], p0[1]), cvtpk_s(p0[2], p0[3]), cvtpk_s(p0[4], p0[5]), cvtpk_s(p0[6], p0[7])};
        pw1 = (u32x4){cvtpk_s(p0[8], p0[9]), cvtpk_s(p0[10], p0[11]), cvtpk_s(p0[12], p0[13]), cvtpk_s(p0[14], p0[15])};
        pw2 = (u32x4){cvtpk_s(p1[0], p1[1]), cvtpk_s(p1[2], p1[3]), cvtpk_s(p1[4], p1[5]), cvtpk_s(p1[6], p1[7])};
        pw3 = (u32x4){cvtpk_s(p1[8], p1[9]), cvtpk_s(p1[10], p1[11]), cvtpk_s(p1[12], p1[13]), cvtpk_s(p1[14], p1[15])};
        if (j > 0) asm volatile("s_waitcnt vmcnt(8)" ::: "memory"); else asm volatile("s_waitcnt vmcnt(0)" ::: "memory");
        pv(o, vb0, __builtin_bit_cast(bf16x8, pw0), __builtin_bit_cast(bf16x8, pw1), __builtin_bit_cast(bf16x8, pw2), __builtin_bit_cast(bf16x8, pw3));
        const bool done = __all(Cc == 0.f);
        if (done) break;
        if (j > 0) SB_DMA_V(j - 1);
    }
    asm volatile("s_waitcnt vmcnt(0) lgkmcnt(0)" ::: "memory");
    bf16* Ow = O + ((size_t)b * SEQ + qb * 256 + wid * 32) * DM + h * HD;
    { LAS bf16* stg = (LAS bf16*)kslot;
#pragma unroll
        for (int r = 0; r < 16; ++r) { const int orow = crow(r, hi);
#pragma unroll
            for (int d0 = 0; d0 < 2; ++d0) stg[orow * 64 + d0 * 32 + r32] = (bf16)f2bf(o[d0][r]); }
        LDS_WAIT();
#pragma unroll
        for (int i = 0; i < 4; ++i) { const int row = i * 8 + (lane >> 3), ch = lane & 7; const u32x4 v = *(const LAS u32x4*)(stg + row * 64 + ch * 8); *(u32x4*)(Ow + (size_t)row * DM + ch * 8) = v; } }
    asm volatile("s_waitcnt lgkmcnt(0)" ::: "memory");
#undef SB_DMA_K
#undef SB_DMA_V
}
__device__ __forceinline__ void sb_unit_win(int b, int h, int qb, const bf16* Q, const bf16* __restrict__ K, const bf16* __restrict__ V, bf16* O, LAS unsigned char* shm) {
    int tid_ = threadIdx.x; asm volatile("" : "+v"(tid_));
    const int tid = tid_, lane = tid & 63, r32 = lane & 31, hi = lane >> 5; const int wid = __builtin_amdgcn_readfirstlane(tid >> 6);
    const bf16* Qw = Q + ((size_t)b * SEQ + qb * 256 + wid * 32) * DM + h * HD;
    const bf16* Kh = K + (size_t)b * KROWS * DM + h * HD; const bf16* Vh = V + (size_t)b * KROWS * DM + h * HD;
    const unsigned lds0 = (unsigned)(uintptr_t)shm;
    const bf16* ksrc = Kh + (size_t)lane * DM + wid * 8;
    const bf16* vsrc = Vh + (size_t)(16 * (wid & 3) + (lane >> 2)) * DM + (wid >> 2) * 32 + (lane & 3) * 8;
    const int vb0 = (int)(lds0 + 8192) + ((lane >> 4) & 1) * 32 + (lane & 3) * 8 + (4 * hi + ((lane & 15) >> 2)) * 64;
    const int qrel = wid * 32 + r32;
    const int jhi = 4 * qb + 1 + (wid >> 1);
    LAS unsigned* flags = (LAS unsigned*)(shm + 7 * 16384);
    bf16x8 qr[4];
#pragma unroll
    for (int d0 = 0; d0 < 4; ++d0) qr[d0] = *(const bf16x8*)(Qw + (size_t)r32 * DM + d0 * 16 + hi * 8);
    f32x16 o[2]; o[0] = f32x16{}; o[1] = f32x16{};
    float Cc = 1.f; const f32x16 zero16 = f32x16{}; bool done = false;
    int jtop = 4 * qb + 4;
    for (;;) {
        const int jlo = jtop > 6 ? jtop - 6 : 0;
        for (int j = jtop; j >= jlo; --j) { const unsigned so = (unsigned)(jtop - j) * 16384u;
            glds16(ksrc + (size_t)j * 64 * DM, (unsigned)__builtin_amdgcn_readfirstlane((int)(lds0 + so + wid * 1024)));
            glds16(vsrc + (size_t)j * 64 * DM, (unsigned)__builtin_amdgcn_readfirstlane((int)(lds0 + so + 8192 + wid * 1024))); }
        asm volatile("s_waitcnt vmcnt(0) lgkmcnt(0)\n\ts_barrier" ::: "memory");
        f32x16 n0 = zero16, n1 = zero16;
        if (!done) qkt(n0, n1, shm + (jtop - (jhi < jtop ? jhi : jtop)) * 16384, qr, zero16, r32, hi);
        if (!done) for (int j = (jhi < jtop ? jhi : jtop); j >= jlo; --j) {
            const int so = (jtop - j) * 16384;
            f32x16 p0 = n0, p1 = n1;
            if (j > jlo) qkt(n0, n1, shm + so + 16384, qr, zero16, r32, hi);
            const int jb = j - (4 * qb + 1);
            {
                float A0[16], A1[16], G[8];
#pragma unroll
                for (int g = 0; g < 4; ++g) {
                    float w0[4], w1[4], b0[4], b1[4];
#pragma unroll
                    for (int i = 0; i < 4; ++i) { const int r = 4 * g + i;
                        const float e0 = fexp2(__builtin_amdgcn_fmed3f(p0[r], -3.0e38f, 80.f)), e1 = fexp2(__builtin_amdgcn_fmed3f(p1[r], -3.0e38f, 80.f));
                        b0[i] = frcp(1.f + e0); b1[i] = frcp(1.f + e1); w0[i] = e0 * b0[i]; w1[i] = e1 * b1[i]; }
                    if (j == jhi || j == 0) {
#pragma unroll
                        for (int i = 0; i < 4; ++i) { const int k0 = crow(4 * g + i, hi), k1 = k0 + 32;
                            const bool v0 = (j == 0) ? (k0 >= 48) : (64 * jb + k0 < qrel), v1 = (j == 0) ? (k1 >= 48) : (64 * jb + k1 < qrel);
                            b0[i] = v0 ? b0[i] : 0.f; w0[i] = v0 ? w0[i] : 1.f; b1[i] = v1 ? b1[i] : 0.f; w1[i] = v1 ? w1[i] : 1.f; }
                    }
                    { const float t2 = w0[3], t1 = t2 * w0[2], t0 = t1 * w0[1]; G[g] = t0 * w0[0]; A0[4 * g + 3] = b0[3]; A0[4 * g + 2] = b0[2] * t2; A0[4 * g + 1] = b0[1] * t1; A0[4 * g] = b0[0] * t0; }
                    { const float t2 = w1[3], t1 = t2 * w1[2], t0 = t1 * w1[1]; G[4 + g] = t0 * w1[0]; A1[4 * g + 3] = b1[3]; A1[4 * g + 2] = b1[2] * t2; A1[4 * g + 1] = b1[1] * t1; A1[4 * g] = b1[0] * t0; }
                }
                float GG[16];
#pragma unroll
                for (int g = 0; g < 8; ++g) { float oh; const float ol = swap_lo(G[g], oh); GG[2 * g] = ol; GG[2 * g + 1] = oh; }
                float Tx[16]; Tx[15] = Cc;
#pragma unroll
                for (int x = 14; x >= 0; --x) Tx[x] = Tx[x + 1] * GG[x + 1];
                Cc = Tx[0] * GG[0];
#pragma unroll
                for (int g = 0; g < 4; ++g) { const float t0 = hi ? Tx[2 * g + 1] : Tx[2 * g], t1 = hi ? Tx[8 + 2 * g + 1] : Tx[8 + 2 * g];
#pragma unroll
                    for (int i = 0; i < 4; ++i) { p0[4 * g + i] = A0[4 * g + i] * t0; p1[4 * g + i] = A1[4 * g + i] * t1; } }
            }
            u32x4 pw0, pw1, pw2, pw3;
            pw0 = (u32x4){cvtpk_s(p0[0], p0[1]), cvtpk_s(p0[2], p0[3]), cvtpk_s(p0[4], p0[5]), cvtpk_s(p0[6], p0[7])};
            pw1 = (u32x4){cvtpk_s(p0[8], p0[9]), cvtpk_s(p0[10], p0[11]), cvtpk_s(p0[12], p0[13]), cvtpk_s(p0[14], p0[15])};
            pw2 = (u32x4){cvtpk_s(p1[0], p1[1]), cvtpk_s(p1[2], p1[3]), cvtpk_s(p1[4], p1[5]), cvtpk_s(p1[6], p1[7])};
            pw3 = (u32x4){cvtpk_s(p1[8], p1[9]), cvtpk_s(p1[10], p1[11]), cvtpk_s(p1[12], p1[13]), cvtpk_s(p1[14], p1[15])};
            pv(o, vb0 + so, __builtin_bit_cast(bf16x8, pw0), __builtin_bit_cast(bf16x8, pw1), __builtin_bit_cast(bf16x8, pw2), __builtin_bit_cast(bf16x8, pw3));
            done = __all(Cc == 0.f);
            if (done) break;
        }
        if (lane == 0) flags[wid] = done ? 1u : 0u;
        asm volatile("s_waitcnt lgkmcnt(0)\n\ts_barrier" ::: "memory");
        const u32x4 fa = *(const LAS u32x4*)flags, fb = *(const LAS u32x4*)(flags + 4);
        const bool alldone = (fa.x & fa.y & fa.z & fa.w & fb.x & fb.y & fb.z & fb.w) != 0u;
        if (alldone || jlo == 0) break;
        jtop = jlo - 1;
        asm volatile("s_waitcnt lgkmcnt(0)\n\ts_barrier" ::: "memory");
    }
    bf16* Ow = O + ((size_t)b * SEQ + qb * 256 + wid * 32) * DM + h * HD;
    { LAS bf16* stg = (LAS bf16*)(shm + wid * 4096);
#pragma unroll
        for (int r = 0; r < 16; ++r) { const int orow = crow(r, hi);
#pragma unroll
            for (int d0 = 0; d0 < 2; ++d0) stg[orow * 64 + d0 * 32 + r32] = (bf16)f2bf(o[d0][r]); }
        LDS_WAIT();
#pragma unroll
        for (int i = 0; i < 4; ++i) { const int row = i * 8 + (lane >> 3), ch = lane & 7; const u32x4 v = *(const LAS u32x4*)(stg + row * 64 + ch * 8); *(u32x4*)(Ow + (size_t)row * DM + ch * 8) = v; } }
    asm volatile("s_waitcnt lgkmcnt(0)\n\ts_barrier" ::: "memory");
}
#undef ATT_WAIT_BAR
}
namespace fox {
using f32x4_=__attribute__((ext_vector_type(4)))float;
constexpr int D=64,NW=8,QBLK=32,QB=QBLK*NW,KVBLK=64;
__device__ __forceinline__ int crow(int r,int hi){return (r&3)+8*(r>>2)+4*hi;}
#define SBAR() __builtin_amdgcn_sched_barrier(0)
__device__ __forceinline__ void cmask(f32x16&p0,f32x16&p1,int jb,int qrel,int hi){
  const float NEG=-INFINITY; int kb=64*jb+4*hi;
  #pragma unroll
  for(int r=0;r<16;++r){int kv=kb+(r&3)+8*(r>>2); if(kv>qrel)p0[r]=NEG; if(kv+32>qrel)p1[r]=NEG;}
}

constexpr int NSLOT=3, SLOTB=8192;
constexpr int LDS_K=0, LDS_V=NSLOT*SLOTB, LDS_WS=2*NSLOT*SLOTB, LDS_OST=LDS_WS+NW*64*4, LDS_BYTES=LDS_OST+NW*4096;
__device__ __forceinline__ void glds16(const void*gsrc,unsigned lds_dst){unsigned keep;
  asm volatile("s_mov_b32 %0, m0\n\ts_mov_b32 m0, %2\n\ts_nop 0\n\tglobal_load_lds_dwordx4 %1, off\n\ts_mov_b32 m0, %0":"=&s"(keep):"v"(gsrc),"s"(lds_dst):"memory");}
__device__ __forceinline__ float max3f(float a,float b,float c){float r;asm("v_max3_f32 %0, %1, %2, %3":"=v"(r):"v"(a),"v"(b),"v"(c));return r;}
__device__ __forceinline__ float max2f(float a,float b){float r;asm("v_max_f32_e32 %0, %1, %2":"=v"(r):"v"(a),"v"(b));return r;}
__device__ __forceinline__ float fadd_s(float a,float b){float r;asm("v_add_f32_e32 %0, %1, %2":"=v"(r):"v"(a),"v"(b));return r;}
__device__ __forceinline__ float fsub_s(float a,float b){float r;asm("v_sub_f32_e32 %0, %1, %2":"=v"(r):"v"(a),"v"(b));return r;}
typedef float f32x2_t __attribute__((ext_vector_type(2)));
__device__ __forceinline__ unsigned cvtpk_s(float lo,float hi){f32x2_t v={lo,hi};bf16x2_t b=__builtin_convertvector(v,bf16x2_t);return __builtin_bit_cast(unsigned,b);}
#define WAIT_BAR(N) asm volatile("s_waitcnt vmcnt(" #N ") lgkmcnt(0)\n\ts_barrier":::"memory")

__device__ __forceinline__ void qkt(f32x16&p0,f32x16&p1,const char*Kslot,const bf16x8*qr,const f32x16&negm,int r32,int hi){
  const char*kb=Kslot+hi*1024+r32*16;
  #pragma unroll
  for(int d0=0;d0<4;++d0){
    const bf16x8 b0=*reinterpret_cast<const bf16x8*>(kb+d0*2048);
    const bf16x8 b1=*reinterpret_cast<const bf16x8*>(kb+d0*2048+512);
    if(d0==0){p0=__builtin_amdgcn_mfma_f32_32x32x16_bf16(b0,qr[0],negm,0,0,0);p1=__builtin_amdgcn_mfma_f32_32x32x16_bf16(b1,qr[0],negm,0,0,0);}
    else{p0=__builtin_amdgcn_mfma_f32_32x32x16_bf16(b0,qr[d0],p0,0,0,0);p1=__builtin_amdgcn_mfma_f32_32x32x16_bf16(b1,qr[d0],p1,0,0,0);}}
}
typedef __attribute__((address_space(3))) const char* lds_cptr;
typedef short v4i16_t __attribute__((ext_vector_type(4)));
__device__ __forceinline__ void kload8(bf16x8*kf,lds_cptr kp){
  kf[0]=*(const __attribute__((address_space(3))) bf16x8*)(kp);      kf[1]=*(const __attribute__((address_space(3))) bf16x8*)(kp+512);
  kf[2]=*(const __attribute__((address_space(3))) bf16x8*)(kp+2048); kf[3]=*(const __attribute__((address_space(3))) bf16x8*)(kp+2560);
  kf[4]=*(const __attribute__((address_space(3))) bf16x8*)(kp+4096); kf[5]=*(const __attribute__((address_space(3))) bf16x8*)(kp+4608);
  kf[6]=*(const __attribute__((address_space(3))) bf16x8*)(kp+6144); kf[7]=*(const __attribute__((address_space(3))) bf16x8*)(kp+6656);
}
__device__ __forceinline__ void kload2(bf16x8*kf,lds_cptr kp,int j){ kf[2*j]=*(const __attribute__((address_space(3))) bf16x8*)(kp+j*2048); kf[2*j+1]=*(const __attribute__((address_space(3))) bf16x8*)(kp+j*2048+512); }
__device__ __forceinline__ s16x4 vtr(lds_cptr p){ return __builtin_bit_cast(s16x4,__builtin_amdgcn_ds_read_tr16_b64_v4i16((__attribute__((address_space(3))) v4i16_t*)p)); }
__device__ __forceinline__ float rowmax(const f32x16&p0,const f32x16&p1){
  float a=max3f(p0[0],p0[1],p1[0]),b=max3f(p0[2],p0[3],p1[1]);a=max3f(a,p1[2],p1[3]);
  #pragma unroll
  for(int r=4;r<16;r+=4){a=max3f(a,p0[r],p0[r+1]);b=max3f(b,p0[r+2],p0[r+3]);a=max3f(a,p1[r],p1[r+1]);b=max3f(b,p1[r+2],p1[r+3]);}
  const float m=max2f(a,b);
  auto rr=__builtin_amdgcn_permlane32_swap(__float_as_uint(m),__float_as_uint(m),false,false);
  return max2f(__uint_as_float(rr[0]),__uint_as_float(rr[1]));
}
__device__ __forceinline__ void pv(f32x16*o,int vb,bf16x8 pa0,bf16x8 pa1,bf16x8 pa2,bf16x8 pa3){
  #pragma unroll
  for(int d0=0;d0<2;++d0){s16x4 lo[4],hi[4];
    #pragma unroll
    for(int ks=0;ks<4;++ks){
      asm volatile("ds_read_b64_tr_b16 %0,%1 offset:%c2":"=&v"(lo[ks]):"v"(vb),"i"(d0*4096+ks*1024):"memory");
      asm volatile("ds_read_b64_tr_b16 %0,%1 offset:%c2":"=&v"(hi[ks]):"v"(vb),"i"(d0*4096+ks*1024+512):"memory");}
    asm volatile("s_waitcnt lgkmcnt(0)":::"memory");SBAR();
    #define PK(k) (bf16x8){lo[k][0],lo[k][1],lo[k][2],lo[k][3],hi[k][0],hi[k][1],hi[k][2],hi[k][3]}
    o[d0]=__builtin_amdgcn_mfma_f32_32x32x16_bf16(pa0,PK(0),o[d0],0,0,0);
    o[d0]=__builtin_amdgcn_mfma_f32_32x32x16_bf16(pa1,PK(1),o[d0],0,0,0);
    o[d0]=__builtin_amdgcn_mfma_f32_32x32x16_bf16(pa2,PK(2),o[d0],0,0,0);
    o[d0]=__builtin_amdgcn_mfma_f32_32x32x16_bf16(pa3,PK(3),o[d0],0,0,0);
    #undef PK
  }
}

#define ATTN_STORE16(p,v) (*(u32x4*)(p)=(v))

constexpr int LDS_NB=LDS_BYTES, LDS_SCAN=LDS_NB+KROWS*4, LDS_KAUG=LDS_SCAN+64, LDS_TOTAL=LDS_KAUG+KROWS*16;
static_assert(LDS_TOTAL<=RING_BYTES,"fox lds");
template<int THRL> __device__ __forceinline__ void attn_unit(int b,int h,int qb,const bf16*Q,const bf16*__restrict__ K,const bf16*__restrict__ V,bf16*O,char*shm){
  int tid_=threadIdx.x; asm volatile("":"+v"(tid_));
  const int tid=tid_,lane=tid&63,r32=lane&31,hi=lane>>5; const int wid=__builtin_amdgcn_readfirstlane(tid>>6);
  const long rowbase=(long)b*SEQ, krowbase=(long)b*KROWS; const int q0=qb*QB;
  const bf16*Qw=Q+(rowbase+q0+wid*QBLK)*DM+h*D;
  const bf16*Kh=K+krowbase*DM+h*D,*Vh=V+krowbase*DM+h*D;
  const unsigned lds0=(unsigned)(uintptr_t)shm;
  float*wsf=(float*)(shm+LDS_WS)+wid*64;
  const bf16*ksrc=Kh+(long)lane*DM+wid*8;
  const bf16*vsrc=Vh+(long)(16*(wid&3)+(lane>>2))*DM+(wid>>2)*32+(lane&3)*8;
  const unsigned kdst=lds0+LDS_K+wid*1024, vdst=lds0+LDS_V+wid*1024;
  #define DMA_K(t,slot) glds16(ksrc+(long)(t)*KVBLK*DM,(unsigned)__builtin_amdgcn_readfirstlane(kdst+(slot)))
  #define DMA_V(t,slot) glds16(vsrc+(long)(t)*KVBLK*DM,(unsigned)__builtin_amdgcn_readfirstlane(vdst+(slot)))
  const int vb0=(int)(lds0+LDS_V)+((lane>>4)&1)*32+(lane&3)*8+(4*hi+((lane&15)>>2))*64;
  const char*Kbase=shm+LDS_K; bf16x8 kf[8];
  const lds_cptr shm3=(lds_cptr)shm; const lds_cptr kp0=shm3+LDS_K+hi*1024+r32*16; const lds_cptr vp0=shm3+LDS_V+((lane>>4)&1)*32+(lane&3)*8+(4*hi+((lane&15)>>2))*64;
  const int NT=(q0+QB)/KVBLK+1;
  DMA_K(0,0);DMA_V(0,0);DMA_K(1,SLOTB);
  bf16x8 qr[4];
  #pragma unroll
  for(int d0=0;d0<4;++d0)qr[d0]=*reinterpret_cast<const bf16x8*>(&Qw[(long)r32*DM+d0*16+hi*8]);
  const int qrel=wid*QBLK+r32;
  const __attribute__((address_space(3))) float*nbl=(const __attribute__((address_space(3))) float*)((lds_cptr)shm+LDS_NB);
  const lds_cptr kaugl=(lds_cptr)shm+LDS_KAUG+r32*16;
  const bf16x8 qaug=hi?(bf16x8){0,0,0,0,0,0,0,0}:(bf16x8){0x3F80,0x3F80,0x3F80,0,0,0,0,0};
  const float ft=-nbl[64+q0+qrel];
  float mhat=-ft,l_reg=0.f;f32x16 o[2];o[0]=f32x16{};o[1]=f32x16{};f32x16 negm;
  _Pragma("unroll") for(int r=0;r<16;++r)negm[r]=ft; asm volatile("":"+v"(negm));
  #define NBADD(P0,P1,t) do{ const __attribute__((address_space(3))) f32x4_*nbp_=(const __attribute__((address_space(3))) f32x4_*)nbl+16*(t)+hi; \
    _Pragma("unroll") for(int g_=0;g_<4;++g_){ const f32x4_ n0_=nbp_[2*g_],n1_=nbp_[2*g_+8]; _Pragma("unroll") for(int i_=0;i_<4;++i_){P0[4*g_+i_]+=n0_[i_];P1[4*g_+i_]+=n1_[i_];} } }while(0)
  #define CMASK(P0,P1,t) do{int jb_=(t)-(NT-4); if(jb_>=0)cmask(P0,P1,jb_,qrel,hi);}while(0)
  bool resc=false;
  #define START(P0,P1) do{ const float rm=rowmax(P0,P1); resc=false; \
    { const float dl=max2f(rm,0.f); mhat=fadd_s(mhat,dl);   \
      _Pragma("unroll") for(int r=0;r<16;++r){P0[r]=fsub_s(P0[r],dl);P1[r]=fsub_s(P1[r],dl);} \
      _Pragma("unroll") for(int r=0;r<16;++r)negm[r]=-mhat; asm volatile("":"+v"(negm)); } \
    _Pragma("unroll") for(int r=0;r<16;++r)P0[r]=__builtin_amdgcn_exp2f(P0[r]); }while(0)
  #define RESC() do{ if(resc){ asm volatile("s_waitcnt lgkmcnt(0)":::"memory"); \
      _Pragma("unroll") for(int d_=0;d_<2;++d_) _Pragma("unroll") for(int r=0;r<16;++r)o[d_][r]*=wsf[crow(r,hi)]; } }while(0)
  f32x16 pA0,pA1,pB0,pB1;
  int sl_prev=0,sl_cur=0,sl_next=SLOTB;
  #define ROT() do{sl_prev=sl_cur;sl_cur=sl_next;sl_next=(sl_next==(NSLOT-1)*SLOTB)?0:sl_next+SLOTB;}while(0)
  DMA_K(2,2*SLOTB);
  WAIT_BAR(3);
  qkt(pA0,pA1,Kbase,qr,negm,r32,hi);asm volatile("s_nop 15\n\ts_nop 7":"+v"(pA0),"+v"(pA1));NBADD(pA0,pA1,0);CMASK(pA0,pA1,0);
  START(pA0,pA1);
  _Pragma("unroll") for(int r=0;r<16;++r)pA1[r]=__builtin_amdgcn_exp2f(pA1[r]);
  WAIT_BAR(0);
  DMA_K(3,0);DMA_V(1,SLOTB);
  ROT();
  kload8(kf,kp0+sl_cur);
  WAIT_BAR(2);
  s16x4 vlo[8],vhi[8]; u32x4 pw0,pw1,pw2,pw3;
  #define PKW(P,B) cvtpk_s(P[B],P[B+1])
  #define PAF(k) __builtin_bit_cast(bf16x8,pw##k)
  #define VFR(i) (bf16x8){vlo[i][0],vlo[i][1],vlo[i][2],vlo[i][3],vhi[i][0],vhi[i][1],vhi[i][2],vhi[i][3]}
  #define PIN(x) asm volatile("":"+v"(x))
  #define MX3(a,b,c) __builtin_fmaxf(__builtin_fmaxf((a),(b)),(c))
  #define GAPA(MF,A0,A1,A2,A3,W0,W1,PW) do{ MF; sacc+=A0; sacc+=A1; sacc+=A2; sacc+=A3; PIN(sacc); W0; W1; PIN(PW); SBAR(); }while(0)
  #define EX(v) __builtin_amdgcn_exp2f(v)
  #define GAPB(MF,X,B) do{ MF; X[B]=EX(X[B]); X[B+1]=EX(X[B+1]); X[B+2]=EX(X[B+2]); X[B+3]=EX(X[B+3]); PIN(X); SBAR(); }while(0)
  #define VRD(i) do{ vlo[i]=vtr(vp_+(((i)>>2)*4096+((i)&3)*1024)); vhi[i]=vtr(vp_+(((i)>>2)*4096+((i)&3)*1024+512)); }while(0)
  #define KRD(G,j) do{ if(G){ kload2(kf,kp0+sl_next,j); SBAR(); } }while(0)
  #define STEP(C0,C1,P0,P1,t,GK,GV,GL) do{ SBAR(); \
    const lds_cptr vp_=vp0+sl_prev; \
    const bf16x8 ka0_=*(const __attribute__((address_space(3))) bf16x8*)(kaugl+(t)*1024), ka1_=*(const __attribute__((address_space(3))) bf16x8*)(kaugl+(t)*1024+512); \
    VRD(0); SBAR(); float sacc=(P0[0]+P0[1]); \
    C0=__builtin_amdgcn_mfma_f32_32x32x16_bf16(ka0_,qaug,negm,0,0,0); C1=__builtin_amdgcn_mfma_f32_32x32x16_bf16(ka1_,qaug,negm,0,0,0); SBAR(); \
    GAPA(C0=__builtin_amdgcn_mfma_f32_32x32x16_bf16(kf[0],qr[0],C0,0,0,0), P0[2],P0[3],P0[4],P0[5],     pw0[0]=PKW(P0,0), pw0[1]=PKW(P0,2), pw0); \
    VRD(4); SBAR(); GAPA(C1=__builtin_amdgcn_mfma_f32_32x32x16_bf16(kf[1],qr[0],C1,0,0,0), P0[6],P0[7],P0[8],P0[9],     pw0[2]=PKW(P0,4), pw0[3]=PKW(P0,6), pw0); \
    VRD(1); SBAR(); GAPA(C0=__builtin_amdgcn_mfma_f32_32x32x16_bf16(kf[2],qr[1],C0,0,0,0),   P0[10],P0[11],P0[12],P0[13], pw1[0]=PKW(P0,8), pw1[1]=PKW(P0,10), pw1); \
    VRD(5); SBAR(); GAPA(C1=__builtin_amdgcn_mfma_f32_32x32x16_bf16(kf[3],qr[1],C1,0,0,0),   P0[14],P0[15],P1[0],P1[1],   pw1[2]=PKW(P0,12),pw1[3]=PKW(P0,14), pw1); \
    VRD(2); SBAR(); GAPA(C0=__builtin_amdgcn_mfma_f32_32x32x16_bf16(kf[4],qr[2],C0,0,0,0),   P1[2],P1[3],P1[4],P1[5],     pw2[0]=PKW(P1,0), pw2[1]=PKW(P1,2), pw2); \
    VRD(6); SBAR(); GAPA(C1=__builtin_amdgcn_mfma_f32_32x32x16_bf16(kf[5],qr[2],C1,0,0,0),   P1[6],P1[7],P1[8],P1[9],     pw2[2]=PKW(P1,4), pw2[3]=PKW(P1,6), pw2); \
    VRD(3); SBAR(); GAPA(C0=__builtin_amdgcn_mfma_f32_32x32x16_bf16(kf[6],qr[3],C0,0,0,0),   P1[10],P1[11],P1[12],P1[13], pw3[0]=PKW(P1,8), pw3[1]=PKW(P1,10), pw3); \
    VRD(7); SBAR(); GAPA(C1=__builtin_amdgcn_mfma_f32_32x32x16_bf16(kf[7],qr[3],C1,0,0,0),   P1[14],P1[15],0.f,0.f,       pw3[2]=PKW(P1,12),pw3[3]=PKW(P1,14), pw3); \
    l_reg+=sacc; \
    if(GK){DMA_K((t)+3,sl_cur);} if(GV){DMA_V((t)+1,sl_next);} \
    CMASK(C0,C1,t); \
    { float a=MX3(C0[0],C0[1],C1[0]),b=MX3(C0[2],C0[3],C1[1]); a=MX3(a,C1[2],C1[3]); \
      _Pragma("unroll") for(int r=4;r<16;r+=4){a=MX3(a,C0[r],C0[r+1]);b=MX3(b,C0[r+2],C0[r+3]);a=MX3(a,C1[r],C1[r+1]);b=MX3(b,C1[r+2],C1[r+3]);} \
      float rm=__builtin_fmaxf(a,b); { auto rr=__builtin_amdgcn_permlane32_swap(__float_as_uint(rm),__float_as_uint(rm),false,false); rm=__builtin_fmaxf(__uint_as_float(rr[0]),__uint_as_float(rr[1])); } \
      resc=false; \
      if(__builtin_expect(__any(rm>(float)THRL),0)){ const float dl=__builtin_fmaxf(rm,0.f); mhat+=dl; \
        _Pragma("unroll") for(int r=0;r<16;++r){C0[r]-=dl;C1[r]-=dl;} \
        _Pragma("unroll") for(int r=0;r<16;++r)negm[r]=-mhat; asm volatile("":"+v"(negm)); \
        const float f=__builtin_amdgcn_exp2f(-dl); l_reg*=f; if(hi==0)wsf[r32]=f; resc=true; } } \
    SBAR(); \
    GAPB(o[0]=__builtin_amdgcn_mfma_f32_32x32x16_bf16(PAF(0),VFR(0),o[0],0,0,0), C0,0); \
    GAPB(o[1]=__builtin_amdgcn_mfma_f32_32x32x16_bf16(PAF(0),VFR(4),o[1],0,0,0), C0,4); \
    KRD(GL,0); GAPB(o[0]=__builtin_amdgcn_mfma_f32_32x32x16_bf16(PAF(1),VFR(1),o[0],0,0,0), C0,8); \
    KRD(GL,1); GAPB(o[1]=__builtin_amdgcn_mfma_f32_32x32x16_bf16(PAF(1),VFR(5),o[1],0,0,0), C0,12); \
    KRD(GL,2); GAPB(o[0]=__builtin_amdgcn_mfma_f32_32x32x16_bf16(PAF(2),VFR(2),o[0],0,0,0), C1,0); \
    KRD(GL,3); GAPB(o[1]=__builtin_amdgcn_mfma_f32_32x32x16_bf16(PAF(2),VFR(6),o[1],0,0,0), C1,4); \
    GAPB(o[0]=__builtin_amdgcn_mfma_f32_32x32x16_bf16(PAF(3),VFR(3),o[0],0,0,0), C1,8); \
    GAPB(o[1]=__builtin_amdgcn_mfma_f32_32x32x16_bf16(PAF(3),VFR(7),o[1],0,0,0), C1,12); \
    }while(0)
  int t=1;
  STEP(pB0,pB1,pA0,pA1,1,true,true,true); WAIT_BAR(2); RESC(); ROT();
  pA0=pB0; pA1=pB1; t=2;
  #undef CMASK
  #define CMASK(P0,P1,t) do{}while(0)
  for(;t+5<NT;t+=2){
    STEP(pB0,pB1,pA0,pA1,t,true,true,true);     WAIT_BAR(2); RESC(); ROT();
    STEP(pA0,pA1,pB0,pB1,t+1,true,true,true);   WAIT_BAR(2); RESC(); ROT();
  }
  #undef CMASK
  #define CMASK(P0,P1,t) do{int jb_=(t)-(NT-4); if(jb_>=0)cmask(P0,P1,jb_,qrel,hi);}while(0)
  #define ENDW(tt) do{ if((tt)+3<NT){WAIT_BAR(2);} else if((tt)+2<NT){WAIT_BAR(1);} else {WAIT_BAR(0);} }while(0)
  for(;t+1<NT;t+=2){
    STEP(pB0,pB1,pA0,pA1,t,(t+3<NT),(t+1<NT),(t+1<NT));       ENDW(t);   RESC(); ROT();
    STEP(pA0,pA1,pB0,pB1,t+1,(t+4<NT),(t+2<NT),(t+2<NT));     ENDW(t+1); RESC(); ROT();
  }
  STEP(pB0,pB1,pA0,pA1,NT-1,false,false,false); RESC();
  { float sacc=pB0[0]+pB0[1]; _Pragma("unroll") for(int r=2;r<16;++r)sacc+=pB0[r]; _Pragma("unroll") for(int r=0;r<16;++r)sacc+=pB1[r]; l_reg+=sacc;
    pw0=(u32x4){PKW(pB0,0),PKW(pB0,2),PKW(pB0,4),PKW(pB0,6)};pw1=(u32x4){PKW(pB0,8),PKW(pB0,10),PKW(pB0,12),PKW(pB0,14)};pw2=(u32x4){PKW(pB1,0),PKW(pB1,2),PKW(pB1,4),PKW(pB1,6)};pw3=(u32x4){PKW(pB1,8),PKW(pB1,10),PKW(pB1,12),PKW(pB1,14)};
    SBAR(); pv(o,vb0+sl_cur,PAF(0),PAF(1),PAF(2),PAF(3)); }
  #undef PKW
  #undef PAF
  #undef VFR
  #undef PIN
  #undef MX3
  #undef GAPA
  #undef GAPB
  #undef EX
  #undef VRD
  #undef KRD
  #undef STEP
  #undef ENDW
  {auto rr=__builtin_amdgcn_permlane32_swap(__float_as_uint(l_reg),__float_as_uint(l_reg),false,false);l_reg=__uint_as_float(rr[0])+__uint_as_float(rr[1]);}
  if(hi==0)wsf[32+r32]=l_reg;asm volatile("s_waitcnt lgkmcnt(0)":::"memory");
  float rli[16];
  #pragma unroll
  for(int r=0;r<16;++r)rli[r]=__builtin_amdgcn_rcpf(wsf[32+crow(r,hi)]);
  bf16*Ow=O+(rowbase+q0+wid*QBLK)*DM+h*D;
  { bf16*stg=(bf16*)(shm+LDS_OST)+wid*2048;
    #pragma unroll
    for(int r=0;r<16;++r){const int orow=crow(r,hi);
      #pragma unroll
      for(int d0=0;d0<2;++d0)stg[orow*64+d0*32+r32]=(bf16)f2bf(o[d0][r]*rli[r]);}
    asm volatile("s_waitcnt lgkmcnt(0)":::"memory");
    #pragma unroll
    for(int i=0;i<4;++i){const int row=i*8+(lane>>3),ch=lane&7; const u32x4 v=*(const u32x4*)(stg+row*64+ch*8); ATTN_STORE16(Ow+(long)row*DM+ch*8,v);} }
  asm volatile("s_waitcnt lgkmcnt(0)\n\ts_barrier":::"memory");
  #undef DMA_K
  #undef DMA_V
  #undef NBADD
  #undef CMASK
  #undef START
  #undef RESC
  #undef ROT
}

#undef SBAR
#undef WAIT_BAR
}
#define XB_TMO      128
#define XB_XCNT(j)  (256  + 64 * (j))
#define XB_XSUB(j)  (1280 + 64 * (j))
#define XB_XGEN(j)  (2304 + 64 * (j))
#define XB_TOP      3328
#define XB_TOPGEN   3392
#define XCD_BAR_WORDS 3456
#define XB_SPIN_CAP (1u << 18)

__device__ __forceinline__ unsigned xb_ld(unsigned* p)              { return __hip_atomic_load(p, __ATOMIC_RELAXED, __HIP_MEMORY_SCOPE_AGENT); }
__device__ __forceinline__ unsigned xb_add(unsigned* p, unsigned v) { return __hip_atomic_fetch_add(p, v, __ATOMIC_RELAXED, __HIP_MEMORY_SCOPE_AGENT); }
__device__ __forceinline__ unsigned xb_xcc_id() { return (unsigned)__builtin_amdgcn_s_getreg((3 << 11) | 20) & 0xFu; }
#define XB_SPIN(cond, bar) do { unsigned _sp = 0; while (cond) { __builtin_amdgcn_s_sleep(1); \
    if ((++_sp & 255u) == 0u) { if (xb_ld(&(bar)[XB_TMO])) break; if (_sp > XB_SPIN_CAP) { atomicAdd(&(bar)[XB_TMO], 1u); break; } } } } while (0)

struct XcdBarrier {
    unsigned* bar; unsigned x;
    volatile LAS unsigned* st;
};

__device__ __forceinline__ XcdBarrier xcd_barrier_post(unsigned* bar, volatile LAS unsigned* st) {
    XcdBarrier b; b.bar = bar; b.x = xb_xcc_id(); b.st = st;
    if (threadIdx.x == 0) (void)xb_add(&bar[XB_XCNT(b.x)], 1u);
    return b;
}
__device__ __forceinline__ void xcd_barrier_complete(unsigned* bar, unsigned x, unsigned& nloc, unsigned& nx) {
    const unsigned G = gridDim.x * gridDim.y * gridDim.z;
    unsigned sum, cnt, mine, sp = 0u;
    for (;;) {
        sum = 0u; cnt = 0u; mine = 0u;
#pragma unroll
        for (unsigned j = 0; j < 16; ++j) { const unsigned c = xb_ld(&bar[XB_XCNT(j)]); sum += c; cnt += (c > 0u) ? 1u : 0u; mine = (j == x) ? c : mine; }
        if (sum == G) break;
        __builtin_amdgcn_s_sleep(1);
        if ((++sp & 255u) == 0u) { if (xb_ld(&bar[XB_TMO])) break; if (sp > XB_SPIN_CAP) { atomicAdd(&bar[XB_TMO], 1u); break; } }
    }
    nloc = mine > 0u ? mine : 1u; nx = cnt > 0u ? cnt : 1u;
}

__device__ __forceinline__ void xcd_barrier(const XcdBarrier& b) {
    asm volatile("s_waitcnt vmcnt(0)" ::: "memory");
    __syncthreads();
    if (threadIdx.x == 0) {
        unsigned* bar = b.bar;
        __builtin_amdgcn_s_waitcnt(0);
        unsigned nloc = b.st[0], nx = b.st[1];
        if (nloc == 0u) { xcd_barrier_complete(bar, b.x, nloc, nx); b.st[0] = nloc; b.st[1] = nx; }
        const unsigned old = xb_add(&bar[XB_XSUB(b.x)], 1u);
        const unsigned gen = old / nloc;
        if (old + 1u == (gen + 1u) * nloc) {
            __builtin_amdgcn_fence(__ATOMIC_RELEASE, "agent");
            asm volatile("s_waitcnt vmcnt(0)" ::: "memory");
            const unsigned og = xb_add(&bar[XB_TOP], 1u);
            const unsigned tg = og / nx;
            if (og + 1u == (tg + 1u) * nx) xb_add(&bar[XB_TOPGEN], 1u);
            else XB_SPIN(xb_ld(&bar[XB_TOPGEN]) == tg, bar);
            __builtin_amdgcn_fence(__ATOMIC_ACQUIRE, "agent");
            xb_add(&bar[XB_XGEN(b.x)], 1u);
            asm volatile("s_waitcnt vmcnt(0)" ::: "memory");
        } else {
            XB_SPIN(xb_ld(&bar[XB_XGEN(b.x)]) == gen, bar);
            __builtin_amdgcn_fence(__ATOMIC_ACQUIRE, "agent");
            asm volatile("s_waitcnt vmcnt(0)" ::: "memory");
        }
    }
    __syncthreads();
}
constexpr int NWAVES = 8;
struct Frame {
    LAS unsigned char* lds; volatile LAS unsigned* MISC; gu32* ctl; unsigned char* ws;
    int tid, lane, wave, G, bx;
    const float *x, *meta, *na, *wqkva, *woa, *nkv, *wkvf, *bfg, *kn, *nab, *wqb, *qnb, *wob, *nfd, *wgud, *wdnd, *nfm, *wrt, *wgum, *wdnm; float* out;
};
__device__ __forceinline__ float wave_sum(float v) {
#pragma unroll
    for (int o = 1; o < 64; o <<= 1) v += __shfl_xor(v, o);
    return v;
}
#ifndef FP8_P5
#define FP8_P5 1
#endif
template <bool FP8, bool GAIN, bool CM = false>
__device__ __forceinline__ void tr64(const float* W, int ld, int k0, int nsrc0, const float* gain, float qs, void* WT, int Kp, int drow0, LAS unsigned* scr, int lane, gu32* cmax = nullptr) {
    const int nq = lane & 15, kq = lane >> 4; float cm[4] = {0.f, 0.f, 0.f, 0.f};
    constexpr int KPL = FP8 ? 4 : 2, KI = FP8 ? 128 : 64, NR = KI / (4 * KPL), PITCH = KI / KPL + 1;
#pragma unroll
    for (int r = 0; r < NR; ++r) {
        const int k = k0 + (4 * r + kq) * KPL; f32x4 v[KPL]; float g[KPL];
#pragma unroll
        for (int j = 0; j < KPL; ++j) { v[j] = __builtin_nontemporal_load((const GAS f32x4*)(W + (size_t)(k + j) * ld + nsrc0 + 4 * nq)); if constexpr (GAIN) g[j] = gain[k + j] * qs; else g[j] = qs; }
#pragma unroll
        for (int j = 0; j < KPL; ++j) { v[j] = v[j] * g[j]; if constexpr (CM) {
#pragma unroll
            for (int i = 0; i < 4; ++i) cm[i] = fmaxf(cm[i], fabsf(v[j][i])); } }
#pragma unroll
        for (int i = 0; i < 4; ++i) { unsigned p; if constexpr (FP8) p = pk4_fp8(v[0][i], v[1][i], v[2][i], v[3][i]); else p = pk2(v[0][i], v[1][i]);
            scr[(4 * nq + i) * PITCH + 4 * r + kq] = p; }
    }
    if constexpr (CM) {
#pragma unroll
        for (int i = 0; i < 4; ++i) { float m_ = cm[i]; m_ = fmaxf(m_, __shfl_xor(m_, 16)); m_ = fmaxf(m_, __shfl_xor(m_, 32)); if (kq == 0) __hip_atomic_fetch_max(cmax + drow0 + 4 * nq + i, __builtin_bit_cast(unsigned, m_), RLX_AGENT); } }
    LDS_WAIT(); asm volatile("" ::: "memory");
    constexpr int LPR = 8, RPI = 64 / LPR, NJ = 64 / RPI;
    const int c = lane % LPR;
#pragma unroll
    for (int j = 0; j < NJ; ++j) { const int n = RPI * j + lane / LPR; const LAS unsigned* s = scr + n * PITCH + 4 * c; u32x4 o; o.x = s[0]; o.y = s[1]; o.z = s[2]; o.w = s[3];
        *(GAS u32x4*)((unsigned char*)WT + ((size_t)(drow0 + n) * Kp + k0) * (FP8 ? 1 : 2) + 16 * c) = o; }
    LDS_WAIT(); asm volatile("" ::: "memory");
}
__device__ __forceinline__ int gu_drow(int n0) { return (n0 < FF) ? (n0 / 128) * 256 + (n0 % 128) : ((n0 - FF) / 128) * 256 + 128 + ((n0 - FF) % 128); }
__device__ __forceinline__ void p0_prologue(Frame& F) {
    const int gw = F.bx * NWAVES + F.wave, NGW = F.G * NWAVES, lane = F.lane;
    unsigned char* ws = F.ws;
    constexpr int I_QKV0 = 16 * 48, I_O = 16 * 16, I_GU = 16 * 88, I_DN = 44 * 16, I_KV = 16 * 32;
    constexpr int I_GU8 = 8 * 88, I_DN8 = 22 * 16;
    constexpr int NITEMS = I_QKV0 + I_O + I_GU + I_DN + I_O + I_KV + I_O + NE * I_GU8 + NE * I_DN8 + (FP8_P5 ? I_DN8 : 0);
    LAS unsigned* scr = (LAS unsigned*)(F.lds + F.wave * 16384);
    for (int it = gw; it < NITEMS; it += NGW) {
        int r = it;
        if (r < I_QKV0) { tr64<false, true, true>(F.wqkva, 3 * DM, 64 * (r / 48), 64 * (r % 48), F.na, 1.f, ws + WS_WQKV0, DM, 64 * (r % 48), scr, lane, F.ctl + CM_QKV0); continue; } r -= I_QKV0;
        if (r < I_O) { tr64<false, false>(F.woa, DM, 64 * (r / 16), 64 * (r % 16), nullptr, 1.f, ws + WS_WO0, DM, 64 * (r % 16), scr, lane); continue; } r -= I_O;
        if (r < I_GU) { tr64<false, true, true>(F.wgud, 2 * FF, 64 * (r / 88), 64 * (r % 88), F.nfd, 1.f, ws + WS_WGU0, DM, gu_drow(64 * (r % 88)), scr, lane, F.ctl + CM_GU0); continue; } r -= I_GU;
        if (r < I_DN) { tr64<false, false>(F.wdnd, DM, 64 * (r / 16), 64 * (r % 16), nullptr, 1.f, ws + WS_WDN0, FF, 64 * (r % 16), scr, lane); continue; } r -= I_DN;
        if (r < I_O) { tr64<false, true, true>(F.wqb, DM, 64 * (r / 16), 64 * (r % 16), F.nab, 1.f, ws + WS_WQKV1, DM, 64 * (r % 16), scr, lane, F.ctl + CM_QKV1); continue; } r -= I_O;
        if (r < I_KV) { tr64<false, true, true>(F.wkvf, 2 * DM + NH, 64 * (r / 32), 64 * (r % 32), F.nkv, 1.f, ws + WS_WQKV1, DM, DM + 64 * (r % 32), scr, lane, F.ctl + CM_QKV1); continue; } r -= I_KV;
        if (r < I_O) { tr64<false, false>(F.wob, DM, 64 * (r / 16), 64 * (r % 16), nullptr, 1.f, ws + WS_WO1, DM, 64 * (r % 16), scr, lane); continue; } r -= I_O;
        if (r < NE * I_GU8) { const int e = r / I_GU8, i2 = r % I_GU8;
            tr64<true, true>(F.wgum + (size_t)e * DM * 2 * FF, 2 * FF, 128 * (i2 / 88), 64 * (i2 % 88), F.nfm, QS_WGU, ws + WS_WGU1 + (size_t)e * 2 * FF * DM, DM, gu_drow(64 * (i2 % 88)), scr, lane); continue; } r -= NE * I_GU8;
        if (r < NE * I_DN8) { const int e = r / I_DN8, i2 = r % I_DN8;
            tr64<true, false>(F.wdnm + (size_t)e * FF * DM, DM, 128 * (i2 / 16), 64 * (i2 % 16), nullptr, QS_WDN, ws + WS_WDN1 + (size_t)e * DM * FF, FF, 64 * (i2 % 16), scr, lane); continue; } r -= NE * I_DN8;
        tr64<true, false>(F.wdnd, DM, 128 * (r / 16), 64 * (r % 16), nullptr, QS_WDN, ws + WS_WDN0Q, FF, 64 * (r % 16), scr, lane);
    }
    { bf16* WF = (bf16*)(ws + WS_WSM); bf16* WR = (bf16*)(ws + WS_WSM + 32768);
        for (int i = gw * 64 + lane; i < 16 * DM; i += NGW * 64) { const int n = i >> 10, k = i & 1023;
            WF[i] = (bf16)f2bf(F.wkvf[(size_t)k * (2 * DM + NH) + 2 * DM + n] * F.nkv[k]);
            const float v = F.wrt[(size_t)k * NE + (n & 7)] * F.nfm[k]; const unsigned hb = f2bf(v); const float hv = __builtin_bit_cast(float, hb << 16);
            WR[i] = (bf16)((n < 8) ? hb : f2bf(v - hv)); } }
    { bf16* H = (bf16*)(ws + WS_H); u64* ss0 = (u64*)(ws + WS_SS0); float* ra0 = (float*)(ws + WS_RA0);
        for (int m = gw; m < T; m += NGW) { const GAS f32x4* xr = (const GAS f32x4*)(F.x + (size_t)m * DM) + lane; f32x4 v[4]; float s = 0.f, mx = 0.f;
#pragma unroll
            for (int j = 0; j < 4; ++j) { v[j] = __builtin_nontemporal_load(xr + 64 * j); s += (v[j].x * v[j].x + v[j].y * v[j].y) + (v[j].z * v[j].z + v[j].w * v[j].w);
                mx = fmaxf(fmaxf(mx, fmaxf(fabsf(v[j].x), fabsf(v[j].y))), fmaxf(fabsf(v[j].z), fabsf(v[j].w))); }
            s = wave_sum(s);
#pragma unroll
            for (int o = 1; o < 64; o <<= 1) mx = fmaxf(mx, __shfl_xor(mx, o));
            if (lane == 0) { ss0[m] = to_fx(s); ra0[m] = frsq(s * (1.f / DM) + EPS) * (mx * (1.f / 127.f)); }
            { const float qi = mx > 0.f ? 127.f / mx : 0.f; GAS unsigned* o4 = (GAS unsigned*)(ws + WS_H8 + (size_t)m * DM) + lane;
#pragma unroll
                for (int j = 0; j < 4; ++j) o4[64 * j] = pk4_i8(v[j].x * qi, v[j].y * qi, v[j].z * qi, v[j].w * qi); }
            GAS unsigned long long* o8 = (GAS unsigned long long*)(H + (size_t)m * DM) + lane;
#pragma unroll
            for (int j = 0; j < 4; ++j) o8[64 * j] = (unsigned long long)pk2(v[j].x, v[j].y) | ((unsigned long long)pk2(v[j].z, v[j].w) << 32); } }
    { GAS u32x4* z = (GAS u32x4*)(ws + Z_SS1); const int nz = (int)((Z_KSQM + 2048 - Z_SS1) / 16); for (int i = gw * 64 + lane; i < nz; i += NGW * 64) z[i] = (u32x4){0u, 0u, 0u, 0u}; }
    { for (int m = gw; m < 2 * NB * 48; m += NGW) { const int which = m / (NB * 48), rr = m % (NB * 48), b = rr / 48, kr = rr % 48;
            GAS u32x4* p = (GAS u32x4*)(ws + (which ? WS_V : WS_K) + ((size_t)b * KROWS + kr) * DM * 2) + lane; p[0] = (u32x4){0u, 0u, 0u, 0u}; p[64] = (u32x4){0u, 0u, 0u, 0u}; } }
}

__device__ __forceinline__ void quant_rows_i8(Frame& F, const bf16* src, unsigned char* dst, const gu32* cmax, int R) {
    for (int r = F.bx * NWAVES + F.wave; r < R; r += F.G * NWAVES) {
        const float mx = __builtin_bit_cast(float, __hip_atomic_load(cmax + r, RLX_AGENT)); const float qi = mx > 0.f ? 127.f / mx : 0.f;
        const GAS u32x4* s = (const GAS u32x4*)(src + (size_t)r * DM) + 2 * F.lane; const u32x4 a = s[0], b = s[1]; u32x4 o;
        o.x = pk4_i8(bflo(a.x) * qi, bfhi(a.x) * qi, bflo(a.y) * qi, bfhi(a.y) * qi); o.y = pk4_i8(bflo(a.z) * qi, bfhi(a.z) * qi, bflo(a.w) * qi, bfhi(a.w) * qi);
        o.z = pk4_i8(bflo(b.x) * qi, bfhi(b.x) * qi, bflo(b.y) * qi, bfhi(b.y) * qi); o.w = pk4_i8(bflo(b.z) * qi, bfhi(b.z) * qi, bflo(b.w) * qi, bfhi(b.w) * qi);
        *((GAS u32x4*)(dst + (size_t)r * DM) + F.lane) = o; }
}
__device__ __forceinline__ void meta_stage_norm(Frame& F, const float* src  ) {
    LAS float* rsv = (LAS float*)(F.lds + 98304); LAS bf16* xm = (LAS bf16*)F.lds;
    for (int r = F.wave; r < 16; r += NWAVES) { float s = 0.f; for (int k = F.lane; k < DM; k += 64) { const float v = src[r * DM + k]; s += v * v; } s = wave_sum(s); if (F.lane == 0) rsv[r] = frsq(s * (1.f / DM) + EPS); }
    __syncthreads();
    for (int i = F.tid; i < 16 * DM; i += NWAVES * 64) xm[i] = (bf16)f2bf(src[i] * rsv[i >> 10]);
    __syncthreads();
}
__device__ __forceinline__ void meta_stage_bf16(Frame& F, const bf16* src, int n) {
    LAS u32x4* xm = (LAS u32x4*)F.lds; const GAS u32x4* s = (const GAS u32x4*)src;
    for (int i = F.tid; i < n / 8; i += NWAVES * 64) xm[i] = s[i];
    __syncthreads();
}
__device__ __forceinline__ int mrow_of(int lane) { return ((lane >> 5) & 1) * 8 + ((lane >> 4) & 1) * 4 + ((lane >> 3) & 1) * 2 + ((lane >> 2) & 1); }
__device__ __forceinline__ float meta_dot(const bf16* wrow, const LAS bf16* xm, int K, int lane) {
    float a[16];
#pragma unroll
    for (int r = 0; r < 16; ++r) a[r] = 0.f;
    for (int k = lane * 8; k < K; k += 512) {
        const u32x4 w = *(const GAS u32x4*)(wrow + k);
        const float w0 = bflo(w.x), w1 = bfhi(w.x), w2 = bflo(w.y), w3 = bfhi(w.y), w4 = bflo(w.z), w5 = bfhi(w.z), w6 = bflo(w.w), w7 = bfhi(w.w);
#pragma unroll
        for (int r = 0; r < 16; ++r) { const u32x4 x = *(const LAS u32x4*)(xm + (size_t)r * K + k);
            a[r] += (w0 * bflo(x.x) + w1 * bfhi(x.x)) + (w2 * bflo(x.y) + w3 * bfhi(x.y)) + (w4 * bflo(x.z) + w5 * bfhi(x.z)) + (w6 * bflo(x.w) + w7 * bfhi(x.w)); }
    }
    float b8[8], b4[4], b2[2], b1;
#pragma unroll
    for (int i = 0; i < 8; ++i) { const bool up = (lane & 32) != 0; const float keep = up ? a[i + 8] : a[i], send = up ? a[i] : a[i + 8]; b8[i] = keep + __shfl_xor(send, 32); }
#pragma unroll
    for (int i = 0; i < 4; ++i) { const bool up = (lane & 16) != 0; const float keep = up ? b8[i + 4] : b8[i], send = up ? b8[i] : b8[i + 4]; b4[i] = keep + __shfl_xor(send, 16); }
#pragma unroll
    for (int i = 0; i < 2; ++i) { const bool up = (lane & 8) != 0; const float keep = up ? b4[i + 2] : b4[i], send = up ? b4[i] : b4[i + 2]; b2[i] = keep + __shfl_xor(send, 8); }
    { const bool up = (lane & 4) != 0; const float keep = up ? b2[1] : b2[0], send = up ? b2[0] : b2[1]; b1 = keep + __shfl_xor(send, 4); }
    b1 += __shfl_xor(b1, 2); b1 += __shfl_xor(b1, 1);
    return b1;
}
__device__ __forceinline__ float silu_f(float g) { return g * frcp(1.f + fexp2(-g * LOG2E)); }

__device__ __forceinline__ f32x4 skinny16(const bf16* Arow0, const bf16* W16, int fr, int fq) {
    f32x4 acc = {0.f, 0.f, 0.f, 0.f};
    const bf16x8* ap = (const bf16x8*)(Arow0 + (size_t)fr * DM + fq * 8);
    const bf16x8* wp = (const bf16x8*)(W16 + (size_t)fr * DM + fq * 8);
#pragma unroll 8
    for (int ks = 0; ks < 32; ++ks) acc = __builtin_amdgcn_mfma_f32_16x16x32_bf16(wp[ks * 4], ap[ks * 4], acc, 0, 0, 0);
    return acc;
}

__device__ __forceinline__ int moe_tables(Frame& F) {
    LAS int* tab = (LAS int*)(F.lds + L_TAB);
    if (F.tid == 0) { int base = 0;
        for (int e = 0; e < NE; ++e) { int c = (int)__hip_atomic_load(F.ctl + CW_CNT + 64 * e, RLX_AGENT); c = c < 0 ? 0 : (c > T ? T : c); const int nt_ = (c + 255) >> 8; tab[288 + e] = c; tab[272 + e] = base; for (int t = 0; t < nt_; ++t) tab[base + t] = e; base += nt_; }
        tab[272 + NE] = base; }
    __syncthreads();
    return tab[272 + NE];
}
constexpr int NPHASE = 13;
#ifndef I8_P4
#define I8_P4 1
#endif
#define LASTREP(k) (args.dry != (k))
struct Args { const float* in[20]; float* out; unsigned char* ws; int ph_lo, ph_hi, li, dry; };
__global__ void __launch_bounds__(NWAVES * 64, 2) yoco_fwd(Args args) {
    extern __shared__ __attribute__((aligned(16))) unsigned char lds_raw[];
    Frame F;
    F.lds = (LAS unsigned char*)lds_raw;
    F.MISC = (volatile LAS unsigned*)(F.lds + L_MISC);
    F.tid = threadIdx.x; F.lane = F.tid & 63; F.wave = __builtin_amdgcn_readfirstlane(F.tid >> 6);
    F.G = gridDim.x; F.bx = blockIdx.x;
    unsigned char* ws = args.ws; F.ws = ws;
    F.ctl = (gu32*)ws;
    F.x = args.in[0]; F.meta = args.in[1]; F.na = args.in[2]; F.wqkva = args.in[3]; F.woa = args.in[4]; F.nkv = args.in[5]; F.wkvf = args.in[6]; F.bfg = args.in[7]; F.kn = args.in[8];
    F.nab = args.in[9]; F.wqb = args.in[10]; F.qnb = args.in[11]; F.wob = args.in[12]; F.nfd = args.in[13]; F.wgud = args.in[14]; F.wdnd = args.in[15]; F.nfm = args.in[16]; F.wrt = args.in[17];
    F.wgum = args.in[18]; F.wdnm = args.in[19]; F.out = args.out;
    for (int u = F.tid; u < 64; u += NWAVES * 64) ((LAS unsigned*)(F.lds + L_MISC))[u] = 0u;
    __syncthreads();
    const int lo = args.ph_lo, hi = args.ph_hi;
    XcdBarrier bar; bar.bar = (unsigned*)(F.ctl + CW_BAR) + args.li * XCD_BAR_WORDS; bar.x = 0; bar.st = nullptr;
    if (hi - lo > 1) bar = xcd_barrier_post((unsigned*)(F.ctl + CW_BAR) + args.li * XCD_BAR_WORDS, F.MISC + 8);
#define IN(k) (lo <= (k) && (k) < hi)
#define SEAM(k) do { if (IN(k) && IN((k) + 1)) xcd_barrier(bar); } while (0)
    bf16* const Hb = (bf16*)(ws + WS_H); bf16* const Qb = (bf16*)(ws + WS_Q); bf16* const Ob = (bf16*)(ws + WS_ACT);
    bf16* const Kb = (bf16*)(ws + WS_K); bf16* const Vb = (bf16*)(ws + WS_V);
    u64* const SS0 = (u64*)(ws + WS_SS0); u64* const SS1 = (u64*)(ws + Z_SS1); u64* const SS2 = (u64*)(ws + Z_SS2); u64* const SS3 = (u64*)(ws + Z_SS3);
    u64* const KSQM = (u64*)(ws + Z_KSQM); float* const LF = (float*)(ws + WS_LF);
    unsigned char* const MT = ws + WS_META;
    bf16* const QM = (bf16*)(MT + MO_QM); bf16* const KM = (bf16*)(MT + MO_KM); bf16* const VM = (bf16*)(MT + MO_VM); bf16* const OM = (bf16*)(MT + MO_OM);
    float* const M1 = (float*)(MT + MO_M1); float* const M2 = (float*)(MT + MO_M2); bf16* const ACTM = (bf16*)(MT + MO_ACTM); float* const KMRAW = (float*)(MT + MO_KMRAW);
    const LAS bf16* const xm = (const LAS bf16*)F.lds;
    const int bx = F.bx, G = F.G;
#define PHASE_IDS() { int t_ = threadIdx.x; asm volatile("" : "+v"(t_)); F.tid = t_; F.lane = t_ & 63; F.wave = __builtin_amdgcn_readfirstlane(t_ >> 6); } const int lane = F.lane, wave = F.wave; const bool mlane = (lane & 3) == 0; const int mr = mrow_of(lane); (void)wave; (void)mlane; (void)mr

    if (IN(0)) { PHASE_IDS(); p0_prologue(F); }
    SEAM(0);
    if (IN(1)) { PHASE_IDS();
        meta_stage_norm(F, F.meta);
        for (int c = bx + G * wave; c < 3 * DM; c += G * NWAVES) {
            const float v = meta_dot((const bf16*)(ws + WS_WQKV0) + (size_t)c * DM, xm, DM, lane);
            if (mlane) { const int sect = c >> 10, cc = c & 1023;
                if (sect == 0) QM[mr * DM + cc] = (bf16)f2bf(v * (-C2));
                else { const bf16 bv = (bf16)f2bf(v); (sect == 1 ? KM : VM)[mr * DM + cc] = bv; bf16* dst = (sect == 1 ? Kb : Vb) + (size_t)(48 + mr) * DM + cc;
                    for (int b = 0; b < NB; ++b) dst[(size_t)b * KROWS * DM] = bv; } }
        }
        quant_rows_i8(F, (const bf16*)(ws + WS_WQKV0), ws + WS_WQKV0Q, F.ctl + CM_QKV0, 3 * DM);
        if (hi - lo > 1) xcd_barrier(bar); else __syncthreads();
        pg8::DenseSched S{T / 256, 12, G, bx, (const char*)(ws + WS_H8), (const char*)(ws + WS_WQKV0Q), (size_t)256 * DM, (size_t)256 * DM};
        pg8::EpiQKV0I8 E{Qb, Kb, Vb, (const float*)(ws + WS_RA0), (const unsigned*)(F.ctl + CM_QKV0), -C2};
        pg8::gemm_phase<pg8::EpiQKV0I8, pg8::DenseSched, true, 2>(F.lds, DM, S, E);
    }
    SEAM(1);
    if (IN(2)) { PHASE_IDS();
        if (bx < NH) {
            LAS float* be = (LAS float*)F.lds; LAS float* we = be + 256; LAS bf16* qs = (LAS bf16*)(F.lds + 2048); LAS bf16* ks = qs + 1024; LAS bf16* vs = ks + 1024;
            if (F.tid < 384) { const int which = F.tid >> 7, i = F.tid & 127, r = i >> 3, c = i & 7;
                const bf16* src = (which == 0 ? QM : which == 1 ? KM : VM) + r * DM + bx * HD + c * 8;
                *(LAS u32x4*)((which == 0 ? qs : which == 1 ? ks : vs) + r * 64 + c * 8) = *(const GAS u32x4*)src; }
            __syncthreads();
            if (F.tid < 256) { const int t = F.tid >> 4, s = F.tid & 15; float z = 0.f;
#pragma unroll 8
                for (int d = 0; d < HD; ++d) z += bf2f(qs[t * 64 + d]) * bf2f(ks[s * 64 + d]);
                const float e = fexp2(fminf(z, 80.f)); float b_ = frcp(1.f + e), w_ = e * b_; if (s >= t) { b_ = 0.f; w_ = 1.f; } be[F.tid] = b_; we[F.tid] = w_; }
            __syncthreads();
            for (int i = F.tid; i < 16 * HD; i += NWAVES * 64) { const int t = i >> 6, d = i & 63; float run = 1.f, o = 0.f;
                for (int s = t - 1; s >= 0; --s) { o += be[t * 16 + s] * run * bf2f(vs[s * 64 + d]); run *= we[t * 16 + s]; }
                OM[t * DM + bx * HD + d] = (bf16)f2bf(o); }
            __syncthreads();
        }
        for (int bh = bx; bh < NB * NH; bh += G)
            for (int qb = 0; qb < SEQ / 256; ++qb) att::sb_unit_win(bh >> 4, bh & 15, qb, Qb, Kb, Vb, Ob, F.lds);
        __syncthreads();
    }
    SEAM(2);
    if (IN(3)) { PHASE_IDS();
        meta_stage_bf16(F, OM, 16 * DM);
        for (int c = bx + G * wave; c < DM; c += G * NWAVES) {
            const float v = meta_dot((const bf16*)(ws + WS_WO0) + (size_t)c * DM, xm, DM, lane);
            if (mlane) M1[mr * DM + c] = F.meta[mr * DM + c] + v; }
        quant_rows_i8(F, (const bf16*)(ws + WS_WGU0), ws + WS_WGU0Q, F.ctl + CM_GU0, 2 * FF);
        quant_rows_i8(F, (const bf16*)(ws + WS_WQKV1), ws + WS_WQKV1Q, F.ctl + CM_QKV1, 3 * DM);
        __syncthreads();
        pg8::DenseSched S{T / 256, 4, G, bx, (const char*)Ob, (const char*)(ws + WS_WO0), (size_t)256 * DM * 2, (size_t)256 * DM * 2};
        pg8::EpiResidT<2> E{Hb, LASTREP(3) ? SS1 : (u64*)(ws + WS_TOKINFO), ws + WS_H8, LASTREP(3) ? Hb : (bf16*)(ws + WS_MACT), SS0};
        pg8::gemm_phase<pg8::EpiResidT<2>, pg8::DenseSched, true>(F.lds, 2 * DM, S, E);
    }
    SEAM(3);
    if (IN(4)) { PHASE_IDS();
        meta_stage_norm(F, M1);
        for (int j = bx + G * wave; j < FF; j += G * NWAVES) {
            const bf16* wg = (const bf16*)(ws + WS_WGU0) + (size_t)((j >> 7) * 256 + (j & 127)) * DM;
            const float g = meta_dot(wg, xm, DM, lane), u = meta_dot(wg + (size_t)128 * DM, xm, DM, lane);
            if (mlane) ACTM[mr * FF + j] = (bf16)f2bf(silu_f(g) * u); }
        __syncthreads();
#if I8_P4
        pg8::DenseSched S{T / 256, 2 * FF / 256, G, bx, (const char*)(ws + WS_H8), (const char*)(ws + WS_WGU0Q), (size_t)256 * DM, (size_t)256 * DM};
        pg8::EpiSwigluI8T<FP8_P5 != 0> E{(bf16*)(ws + WS_ACT), SS1, SS0, (const unsigned*)(F.ctl + CM_GU0)};
        pg8::gemm_phase<pg8::EpiSwigluI8T<FP8_P5 != 0>, pg8::DenseSched, true, 2>(F.lds, DM, S, E);
#else
        pg8::DenseSched S{T / 256, 2 * FF / 256, G, bx, (const char*)Hb, (const char*)(ws + WS_WGU0), (size_t)256 * DM * 2, (size_t)256 * DM * 2};
        pg8::EpiSwiglu<false> E{(bf16*)(ws + WS_ACT), SS1};
        pg8::gemm_phase<pg8::EpiSwiglu<false>, pg8::DenseSched, true>(F.lds, 2 * DM, S, E);
#endif
    }
    SEAM(4);
    if (IN(5)) { PHASE_IDS();
        meta_stage_bf16(F, ACTM, 16 * FF);
        for (int c = bx + G * wave; c < DM; c += G * NWAVES) {
            const float v = meta_dot((const bf16*)(ws + WS_WDN0) + (size_t)c * FF, xm, FF, lane);
            if (mlane) M2[mr * DM + c] = M1[mr * DM + c] + v; }
        __syncthreads();
#if FP8_P5
        pg8::DenseSched S{T / 256, 4, G, bx, (const char*)(ws + WS_ACT), (const char*)(ws + WS_WDN0Q), (size_t)256 * FF, (size_t)256 * FF};
        pg8::EpiResidT<2, true> E{Hb, LASTREP(5) ? SS2 : (u64*)(ws + WS_TOKINFO), LASTREP(5) ? ws + WS_H8 : ws + WS_MACT + 8 * MiB, LASTREP(5) ? Hb : (bf16*)(ws + WS_MACT), SS1, 1.f / (QS_ACT * QS_WDN)};
        pg8::gemm_phase<pg8::EpiResidT<2, true>, pg8::DenseSched, true, 1>(F.lds, FF, S, E);
#else
        pg8::DenseSched S{T / 256, 4, G, bx, (const char*)(ws + WS_ACT), (const char*)(ws + WS_WDN0), (size_t)256 * FF * 2, (size_t)256 * FF * 2};
        pg8::EpiResidT<2> E{Hb, LASTREP(5) ? SS2 : (u64*)(ws + WS_TOKINFO), LASTREP(5) ? ws + WS_H8 : ws + WS_MACT + 8 * MiB, LASTREP(5) ? Hb : (bf16*)(ws + WS_MACT), SS1};
        pg8::gemm_phase<pg8::EpiResidT<2>, pg8::DenseSched, true>(F.lds, 2 * FF, S, E);
#endif
    }
    SEAM(5);
    if (IN(6)) { PHASE_IDS();
        meta_stage_norm(F, M2);
        for (int c = bx + G * wave; c < 2 * DM + NH; c += G * NWAVES) {
            const bf16* wrow = (c < 2 * DM) ? (const bf16*)(ws + WS_WQKV1) + (size_t)(DM + c) * DM : (const bf16*)(ws + WS_WSM) + (size_t)(c - 2 * DM) * DM;
            const float v = meta_dot(wrow, xm, DM, lane);
            if (mlane) {
                if (c < DM) { KMRAW[mr * DM + c] = v; if (LASTREP(6)) atomicAdd(KSQM + mr * NH + (c >> 6), to_fx(v * v)); }
                else if (c < 2 * DM) { const bf16 bv = (bf16)f2bf(v); bf16* dst = Vb + (size_t)(48 + mr) * DM + (c - DM); for (int b = 0; b < NB; ++b) dst[(size_t)b * KROWS * DM] = bv; }
                else { const int hh = c - 2 * DM; const float fl = v + F.bfg[hh]; const float ls = fminf(fl, 0.f) - __logf(1.f + __expf(-fabsf(fl)));
                    for (int b = 0; b < NB; ++b) LF[((size_t)b * NH + hh) * KROWS + 48 + mr] = ls * LOG2E; } }
        }
        { const int fr = lane & 15, fq = lane >> 4;
            for (int rt = bx * NWAVES + wave; rt < T / 16; rt += G * NWAVES) { const int row = rt * 16 + fr;
                const f32x4 a = skinny16(Hb + (size_t)rt * 16 * DM, (const bf16*)(ws + WS_WSM), fr, fq);
                const float rs = frsq(from_fx(SS2[row]) * (1.f / DM) + EPS);
#pragma unroll
                for (int i = 0; i < 4; ++i) { const int hh = 4 * fq + i; const float fl = a[i] * rs + F.bfg[hh]; const float ls = fminf(fl, 0.f) - __logf(1.f + __expf(-fabsf(fl)));
                    LF[((size_t)(row >> 11) * NH + hh) * KROWS + 64 + (row & 2047)] = ls * LOG2E; } } }
        __syncthreads();
        pg8::DenseSched S{T / 256, 12, G, bx, (const char*)(ws + WS_H8), (const char*)(ws + WS_WQKV1Q), (size_t)256 * DM, (size_t)256 * DM};
        pg8::EpiHeadNormT<true> E{Qb, Kb, Vb, SS2, F.qnb, F.kn, 1.f, SS1, (const unsigned*)(F.ctl + CM_QKV1)};
        pg8::gemm_phase<pg8::EpiHeadNormT<true>, pg8::DenseSched, true, 2>(F.lds, DM, S, E);
    }
    SEAM(6);
    if (IN(7)) { PHASE_IDS();
        for (int bh = bx; bh < NB * NH; bh += G) { const int b = bh >> 4, h = bh & 15;
            for (int i = F.tid; i < NMETA * HD; i += NWAVES * 64) { const int r = i >> 6, d = i & 63;
                const float sc = frsq(from_fx(KSQM[r * NH + h]) * (1.f / HD) + EPS) * F.kn[d];
                Kb[((size_t)b * KROWS + 48 + r) * DM + h * HD + d] = (bf16)f2bf(KMRAW[r * DM + h * HD + d] * sc); }
            { const float* lf = LF + (size_t)bh * KROWS; LAS float* nb = (LAS float*)(F.lds + fox::LDS_NB); LAS float* sc = (LAS float*)(F.lds + fox::LDS_SCAN);
                float v[5]; float run = 0.f;
#pragma unroll
                for (int i = 0; i < 5; ++i) { const int kr = F.tid * 5 + i; const float x = (kr >= 48 && kr < KROWS) ? lf[kr] : 0.f; run += x; v[i] = run; }
                float inc = run;
#pragma unroll
                for (int o = 1; o < 64; o <<= 1) { const float t_ = __shfl_up(inc, o); if (lane >= o) inc += t_; }
                if (lane == 63) sc[wave] = inc;
                __syncthreads();
                float base = inc - run; for (int w = 0; w < wave; ++w) base += sc[w];
#pragma unroll
                for (int i = 0; i < 5; ++i) { const int kr = F.tid * 5 + i; if (kr < KROWS) { const float x = (kr < 48) ? -1e4f : -(base + v[i]); nb[kr] = x;
                    const unsigned hb = f2bf(x); const float r1 = x - __builtin_bit_cast(float, hb << 16); const unsigned mb = f2bf(r1); const float r2 = r1 - __builtin_bit_cast(float, mb << 16); const unsigned lb = f2bf(r2);
                    ((LAS u32x4*)(F.lds + fox::LDS_KAUG))[kr] = (u32x4){hb | (mb << 16), lb, 0u, 0u}; } }
            }
            VM_WAIT(); __syncthreads();
            for (int qb = 0; qb < SEQ / 256; ++qb) fox::attn_unit<8>(b, h, qb, Qb, Kb, Vb, Ob, (char*)lds_raw);
        }
    }
    SEAM(7);
    if (IN(8)) { PHASE_IDS();
        pg8::DenseSched S{T / 256, 4, G, bx, (const char*)Ob, (const char*)(ws + WS_WO1), (size_t)256 * DM * 2, (size_t)256 * DM * 2};
        pg8::EpiResidT<1> E{Hb, LASTREP(8) ? SS3 : (u64*)(ws + WS_TOKINFO), LASTREP(8) ? ws + WS_H8 : ws + WS_MACT + 64 * MiB, LASTREP(8) ? Hb : (bf16*)(ws + WS_MACT)};
        pg8::gemm_phase<pg8::EpiResidT<1>, pg8::DenseSched, true>(F.lds, 2 * DM, S, E);
    }
    SEAM(8);
    if (IN(9)) { PHASE_IDS();
        const bool dry9 = !LASTREP(9);
        int* const list = (int*)(ws + (dry9 ? WS_MACT : WS_LIST)); float* const glist = (float*)(ws + (dry9 ? WS_MACT + 2 * MiB : WS_GLIST)); int* const tokinfo = (int*)(ws + (dry9 ? WS_MACT + 4 * MiB : WS_TOKINFO));
        gu32* const cntw = F.ctl + CW_CNT + (dry9 ? 1024 : 0);
        volatile LAS unsigned* lcnt = F.MISC + 16; volatile LAS unsigned* lbase = F.MISC + 24;
        const int fr = lane & 15, fq = lane >> 4;
        for (int ch = bx; ch < T / 128; ch += G) {
            if (F.tid < 8) lcnt[F.tid] = 0u;
            __syncthreads();
            const int row = ch * 128 + wave * 16 + fr;
            f32x4 a = skinny16(Hb + (size_t)(ch * 128 + wave * 16) * DM, (const bf16*)(ws + WS_WSM + 32768), fr, fq);
            float lg[8];
#pragma unroll
            for (int i = 0; i < 4; ++i) { const float v = a[i] + __shfl_xor(a[i], 32); const float ot = __shfl_xor(v, 16); lg[i] = (fq & 1) ? ot : v; lg[4 + i] = (fq & 1) ? v : ot; }
            const float rs = frsq(from_fx(SS3[row]) * (1.f / DM) + EPS);
            int e0 = 0; float l0 = lg[0];
#pragma unroll
            for (int e = 1; e < 8; ++e) if (lg[e] > l0) { l0 = lg[e]; e0 = e; }
            int e1 = -1; float l1 = -INFINITY;
#pragma unroll
            for (int e = 0; e < 8; ++e) if (e != e0 && lg[e] > l1) { l1 = lg[e]; e1 = e; }
            const float g0 = frcp(1.f + __expf((l1 - l0) * rs)), g1 = 1.f - g0;
            unsigned r0 = 0, r1 = 0;
            if (fq == 0) { r0 = atomicAdd((unsigned*)&lcnt[e0], 1u); r1 = atomicAdd((unsigned*)&lcnt[e1], 1u); }
            __syncthreads();
            if (F.tid < 8) lbase[F.tid] = atomicAdd((unsigned*)(cntw + 64 * F.tid), lcnt[F.tid]);
            __syncthreads();
            if (fq == 0) { const unsigned p0 = lbase[e0] + r0, p1 = lbase[e1] + r1;
                list[(size_t)e0 * T + p0] = row; glist[(size_t)e0 * T + p0] = g0; list[(size_t)e1 * T + p1] = row; glist[(size_t)e1 * T + p1] = g1;
                tokinfo[2 * row] = (int)((p0 << 3) | (unsigned)e0); tokinfo[2 * row + 1] = (int)((p1 << 3) | (unsigned)e1); }
            __syncthreads();
        }
    }
    SEAM(9);
    if (IN(10)) { PHASE_IDS();
        const int nM = moe_tables(F);
        pg8::MoeSched<true> S{nM, 2 * FF / 256, G, bx, (const char*)(ws + WS_H8), (const char*)(ws + WS_WGU1), 0, (size_t)256 * DM, (size_t)2 * FF * DM, (const LAS int*)(F.lds + L_TAB), (const int*)(ws + WS_LIST), (const float*)(ws + WS_GLIST)};
        pg8::EpiSwiglu<true> E{(bf16*)(ws + WS_MACT), SS3};
        pg8::gemm_phase<pg8::EpiSwiglu<true>, pg8::MoeSched<true>, true, 1>(F.lds, DM, S, E);
    }
    SEAM(10);
    if (IN(11)) { PHASE_IDS();
        const int nM = moe_tables(F);
        pg8::MoeSched<false> S{nM, 4, G, bx, (const char*)(ws + WS_MACT), (const char*)(ws + WS_WDN1), (size_t)256 * FF, (size_t)256 * FF, (size_t)DM * FF, (const LAS int*)(F.lds + L_TAB), (const int*)(ws + WS_LIST), (const float*)(ws + WS_GLIST)};
        pg8::EpiMoE2 E{(bf16*)(ws + WS_C)};
        pg8::gemm_phase<pg8::EpiMoE2, pg8::MoeSched<false>, true, 1>(F.lds, FF, S, E);
    }
    SEAM(11);
    if (IN(12)) { PHASE_IDS();
        (void)moe_tables(F);
        const LAS int* tab = (const LAS int*)(F.lds + L_TAB); const int* tokinfo = (const int*)(ws + WS_TOKINFO); const bf16* Cb = (const bf16*)(ws + WS_C);
        const int gwv = bx * NWAVES + wave, NGW = G * NWAVES;
        for (int row0 = gwv; row0 < T; row0 += 2 * NGW) {
            const int row1 = row0 + NGW; const bool has1 = row1 < T; const int r1 = has1 ? row1 : row0;
            const u32x2 ia = *(const GAS u32x2*)(tokinfo + 2 * row0), ib = *(const GAS u32x2*)(tokinfo + 2 * r1);
            const size_t a0 = (size_t)tab[272 + (ia.x & 7)] * 256 + (ia.x >> 3), a1 = (size_t)tab[272 + (ia.y & 7)] * 256 + (ia.y >> 3);
            const size_t b0 = (size_t)tab[272 + (ib.x & 7)] * 256 + (ib.x >> 3), b1 = (size_t)tab[272 + (ib.y & 7)] * 256 + (ib.y >> 3);
            u32x4 hv[2][2], ca[2][2], cb[2][2];
#pragma unroll
            for (int j = 0; j < 2; ++j) {
                hv[0][j] = ((const GAS u32x4*)(Hb + (size_t)row0 * DM) + 2 * lane)[j]; ca[0][j] = ((const GAS u32x4*)(Cb + a0 * DM) + 2 * lane)[j]; cb[0][j] = ((const GAS u32x4*)(Cb + a1 * DM) + 2 * lane)[j];
                hv[1][j] = ((const GAS u32x4*)(Hb + (size_t)r1 * DM) + 2 * lane)[j]; ca[1][j] = ((const GAS u32x4*)(Cb + b0 * DM) + 2 * lane)[j]; cb[1][j] = ((const GAS u32x4*)(Cb + b1 * DM) + 2 * lane)[j]; }
#pragma unroll
            for (int t = 0; t < 2; ++t) { if (t == 1 && !has1) break;
                GAS f32x4* op = (GAS f32x4*)(F.out + (size_t)(t ? row1 : row0) * DM) + 4 * lane;
#pragma unroll
                for (int j = 0; j < 2; ++j) { const u32x4 h_ = hv[t][j], a = ca[t][j], b = cb[t][j];
                    op[2 * j] = (f32x4){bflo(h_.x) + bflo(a.x) + bflo(b.x), bfhi(h_.x) + bfhi(a.x) + bfhi(b.x), bflo(h_.y) + bflo(a.y) + bflo(b.y), bfhi(h_.y) + bfhi(a.y) + bfhi(b.y)};
                    op[2 * j + 1] = (f32x4){bflo(h_.z) + bflo(a.z) + bflo(b.z), bfhi(h_.z) + bfhi(a.z) + bfhi(b.z), bflo(h_.w) + bflo(a.w) + bflo(b.w), bfhi(h_.w) + bfhi(a.w) + bfhi(b.w)}; } }
        }
    }
#undef IN
#undef SEAM
}

#ifndef MK_PER_PHASE
#define MK_PER_PHASE 0
#endif
extern "C" void kernel_launch(void* const* d_in, const int* in_sizes, int n_in, void* d_out, int out_size, void* d_ws, size_t ws_size, hipStream_t stream) {
    static int grid = 0;
    if (grid == 0) {
        if (n_in != 20 || in_sizes[0] != T * DM || out_size != T * DM || ws_size < WS_END) { fprintf(stderr, "kernel_launch: unexpected shapes (n_in %d, in0 %d, out %d, ws %zu < %zu); nothing launched\n", n_in, n_in > 0 ? in_sizes[0] : -1, out_size, ws_size, (size_t)WS_END); grid = -1; return; }
        int dev = 0, cus = 0, per_cu = 0;
        if (hipGetDevice(&dev) != hipSuccess || hipDeviceGetAttribute(&cus, hipDeviceAttributeMultiprocessorCount, dev) != hipSuccess) { grid = -1; return; }
        if (hipFuncSetAttribute((const void*)yoco_fwd, hipFuncAttributeMaxDynamicSharedMemorySize, LDS_BYTES) != hipSuccess) { fprintf(stderr, "kernel_launch: hipFuncSetAttribute failed\n"); grid = -1; return; }
        if (hipOccupancyMaxActiveBlocksPerMultiprocessor(&per_cu, (const void*)yoco_fwd, NWAVES * 64, LDS_BYTES) != hipSuccess || per_cu < 1) { fprintf(stderr, "kernel_launch: occupancy query says %d blocks per CU\n", per_cu); per_cu = 1; }
        (void)hipGetLastError();
        grid = cus;
    }
    if (grid < 0) return;
    if (hipMemsetAsync(d_ws, 0, ZERO_BYTES, stream) != hipSuccess) { fprintf(stderr, "kernel_launch: memset failed\n"); return; }
    Args a{};
    for (int i = 0; i < 20; ++i) a.in[i] = (const float*)d_in[i];
    a.out = (float*)d_out; a.ws = (unsigned char*)d_ws; a.li = 0; a.dry = -1;
#if defined(PROBE_PHASE)
    a.ph_lo = 0; a.ph_hi = PROBE_PHASE + 1; a.li = 0; a.dry = PROBE_PHASE; hipLaunchKernelGGL(yoco_fwd, dim3(grid), dim3(NWAVES * 64), LDS_BYTES, stream, a);
    a.ph_lo = PROBE_PHASE; a.ph_hi = NPHASE; a.li = 1; a.dry = -1; hipLaunchKernelGGL(yoco_fwd, dim3(grid), dim3(NWAVES * 64), LDS_BYTES, stream, a);
#elif MK_PER_PHASE
    for (int p = 0; p < NPHASE; ++p) { a.ph_lo = p; a.ph_hi = p + 1; hipLaunchKernelGGL(yoco_fwd, dim3(grid), dim3(NWAVES * 64), LDS_BYTES, stream, a); }
#else
    a.ph_lo = 0; a.ph_hi = NPHASE; hipLaunchKernelGGL(yoco_fwd, dim3(grid), dim3(NWAVES * 64), LDS_BYTES, stream, a);
#endif
    const hipError_t le = hipPeekAtLastError();
    if (le != hipSuccess) fprintf(stderr, "kernel_launch: launch failed: %s\n", hipGetErrorName(le));
}
```

```cpp
#include <hip/hip_runtime.h>
#include <cstdio>
#include <cstdint>

#define GAS __attribute__((address_space(1)))
#define LAS __attribute__((address_space(3)))
typedef unsigned short bf16;
typedef short bf16x8 __attribute__((ext_vector_type(8)));
typedef short s16x4 __attribute__((ext_vector_type(4)));
typedef float f32x2 __attribute__((ext_vector_type(2)));
typedef float f32x4 __attribute__((ext_vector_type(4)));
typedef float f32x16 __attribute__((ext_vector_type(16)));
typedef unsigned u32x2 __attribute__((ext_vector_type(2)));
typedef unsigned u32x4 __attribute__((ext_vector_type(4)));
typedef __bf16 bf16x2_t __attribute__((ext_vector_type(2)));
typedef GAS unsigned gu32;

constexpr int NB = 16, SEQ = 2048, DM = 1024, NH = 16, HD = 64, FF = 2816, NE = 8, NMETA = 16;
constexpr int T = NB * SEQ;
constexpr int KROWS = 64 + SEQ;
constexpr float EPS = 1e-6f;
constexpr float LOG2E = 1.4426950408889634f;
constexpr float C2 = 0.125f * LOG2E;
constexpr float QS_H = 8.f, QS_WGU = 128.f, QS_ACT = 32.f, QS_WDN = 256.f;
constexpr int MOE_MAXTILES = 2 * T / 256 + NE;

constexpr size_t MiB = 1u << 20;
constexpr size_t ZERO_BYTES = 128 * 1024;
constexpr int CW_TMO = 0, CW_BAR = 4096, CW_CNT = 16384, CW_CMAX = 20480  , CM_GU0 = CW_CMAX, CM_QKV0 = CM_GU0 + 2 * FF, CM_QKV1 = CM_QKV0 + 3 * DM;
static_assert((CM_QKV1 + 3 * DM) * 4 <= (int)ZERO_BYTES, "cmax");
constexpr size_t Z_SS1 = 1 * MiB, Z_SS2 = Z_SS1 + 262144, Z_SS3 = Z_SS2 + 262144, Z_KSQM = Z_SS3 + 262144;
constexpr size_t WS_SS0 = 5 * MiB  , WS_LF = 6 * MiB, WS_LIST = 9 * MiB, WS_GLIST = 10 * MiB, WS_TOKINFO = 11 * MiB;
constexpr size_t WS_META = 12 * MiB;
constexpr size_t MO_QM = 0, MO_KM = 32768, MO_VM = 65536, MO_OM = 98304, MO_M1 = 131072, MO_M2 = 196608, MO_ACTM = 262144, MO_KMRAW = 360448;
constexpr size_t WS_WSM = 13 * MiB;
constexpr size_t WS_WQKV0 = 16 * MiB, WS_WO0 = 22 * MiB, WS_WGU0 = 24 * MiB, WS_WDN0 = 35 * MiB, WS_WQKV1 = 41 * MiB, WS_WO1 = 47 * MiB, WS_WGU1 = 49 * MiB  , WS_H8 = 96 * MiB  , WS_WDN1 = 148 * MiB  ;
constexpr size_t WS_WGU0Q = 176 * MiB;
constexpr size_t WS_WQKV1Q = 172 * MiB;
constexpr size_t WS_WDN0Q = 186 * MiB;
constexpr size_t WS_WQKV0Q = 182 * MiB;
constexpr size_t WS_RA0 = 5 * MiB + 512 * 1024;
constexpr size_t WS_C = 16 * MiB;
constexpr size_t WS_H = 192 * MiB;
constexpr size_t WS_Q = 256 * MiB, WS_K = 320 * MiB, WS_V = 386 * MiB, WS_ACT = 452 * MiB, WS_MACT = 256 * MiB;
constexpr size_t WS_PL = 544 * MiB;
constexpr float PLS = 1048576.f, PLI = 1.f / 1048576.f;
constexpr size_t WS_CP = 452 * MiB;
constexpr size_t WS_RSC = 11 * MiB + 512 * 1024;
constexpr size_t WS_END = 628 * MiB;
static_assert(WS_WGU1 + (size_t)NE * 2 * FF * DM <= WS_H8 && WS_H8 + (size_t)T * DM <= WS_WDN1 && WS_WDN1 + (size_t)NE * DM * FF <= WS_H, "weights");
static_assert(WS_C + (size_t)MOE_MAXTILES * 256 * DM * 2 <= WS_WDN1, "C overlay");
static_assert(WS_K + (size_t)NB * KROWS * DM * 2 <= WS_V && WS_V + (size_t)NB * KROWS * DM * 2 <= WS_ACT && WS_ACT + (size_t)T * FF * 2 <= WS_END, "acts");
static_assert(WS_MACT + (size_t)MOE_MAXTILES * 256 * FF * 2 <= WS_END, "moe act");
static_assert(WS_LF + (size_t)NB * NH * KROWS * 4 <= WS_LIST, "lf");

constexpr int RING_BYTES = 131072;
constexpr int L_MISC = RING_BYTES;
constexpr int L_TAB = RING_BYTES + 256;
constexpr int L_X = RING_BYTES + 2048;
constexpr int L_RS = L_X + 8192;
constexpr int RS_PAR = 5120;
constexpr int L_LG2 = 151552;
constexpr int LDS_BYTES = 159744;
static_assert(L_RS + 2 * RS_PAR <= L_LG2 && L_LG2 + 8192 <= LDS_BYTES && LDS_BYTES <= 163840 && L_TAB + 296 * 4 <= L_X, "lds map");

#define RLX_AGENT __ATOMIC_RELAXED, __HIP_MEMORY_SCOPE_AGENT
#define LDS_WAIT() asm volatile("s_waitcnt lgkmcnt(0)" ::: "memory")
#define VM_WAIT() asm volatile("s_waitcnt vmcnt(0)" ::: "memory")
__device__ __forceinline__ unsigned f2bf(float f) { unsigned u = __builtin_bit_cast(unsigned, f); return (u + 0x7fffu + ((u >> 16) & 1u)) >> 16; }
__device__ __forceinline__ unsigned pk2(float lo, float hi) { return f2bf(lo) | (f2bf(hi) << 16); }
__device__ __forceinline__ float bflo(unsigned u) { return __builtin_bit_cast(float, u << 16); }
__device__ __forceinline__ float bfhi(unsigned u) { return __builtin_bit_cast(float, u & 0xffff0000u); }
__device__ __forceinline__ float bf2f(bf16 v) { return __builtin_bit_cast(float, (unsigned)v << 16); }
__device__ __forceinline__ unsigned cvt_pk_bf16(float lo, float hi) { unsigned r; asm volatile("v_cvt_pk_bf16_f32 %0, %1, %2" : "=v"(r) : "v"(lo), "v"(hi)); return r; }
__device__ __forceinline__ unsigned cvtpk_s(float lo, float hi) { f32x2 v = {lo, hi}; bf16x2_t b = __builtin_convertvector(v, bf16x2_t); return __builtin_bit_cast(unsigned, b); }
__device__ __forceinline__ float fexp2(float x) { return __builtin_amdgcn_exp2f(x); }
__device__ __forceinline__ float frcp(float x) { return __builtin_amdgcn_rcpf(x); }
__device__ __forceinline__ float frsq(float x) { return __builtin_amdgcn_rsqf(x); }
typedef unsigned long long u64;
typedef int v8i __attribute__((ext_vector_type(8)));
typedef int v4i_t __attribute__((ext_vector_type(4)));
#ifndef SATMODE
#define SATMODE 1
#endif
#if SATMODE
__device__ __forceinline__ float clamp8(float x) { return x; }
#else
__device__ __forceinline__ float clamp8(float x) { return __builtin_amdgcn_fmed3f(x, -448.f, 448.f); }
#endif
__device__ __forceinline__ unsigned pk4_fp8(float a, float b, float c, float d) { const float a_ = clamp8(a); int p = __builtin_amdgcn_cvt_pk_fp8_f32(a_, clamp8(b), __builtin_bit_cast(int, a_), false); p = __builtin_amdgcn_cvt_pk_fp8_f32(clamp8(c), clamp8(d), p, true); return (unsigned)p; }
constexpr float FXS = 1048576.f, FXI = 1.f / 1048576.f;
__device__ __forceinline__ u64 to_fx(float s) { return (u64)(s * FXS); }
__device__ __forceinline__ float from_fx(u64 v) { return (float)v * FXI; }
__device__ __forceinline__ void dma4(const void* g, LAS unsigned* l) { __builtin_amdgcn_global_load_lds((const unsigned*)g, l, 4, 0, 0); }
__device__ __forceinline__ float rs_from_planes(const LAS unsigned* RS, int r) { const float v = (float)RS[r] + (float)RS[256 + r] * 4294967296.f; return frsq(v * (FXI / 1024.f) + 1e-6f); }

__device__ __forceinline__ unsigned q8bits(float x) { return __builtin_bit_cast(unsigned, __builtin_amdgcn_fmed3f(x, -127.f, 127.f) + 12582912.f); }
__device__ __forceinline__ unsigned pk4_i8(float a, float b, float c, float d) {
    return (q8bits(a) & 0xffu) | ((q8bits(b) & 0xffu) << 8) | ((q8bits(c) & 0xffu) << 16) | (q8bits(d) << 24); }
constexpr float CQ = 6.f;
__device__ __forceinline__ float ms_from_planes(const LAS unsigned* RS, int r) { return ((float)RS[r] + (float)RS[256 + r] * 4294967296.f) * (FXI / 1024.f) + 1e-6f; }
__device__ __forceinline__ void glds16s(const void* base, unsigned voff, unsigned lds_dst) {
    asm volatile("s_mov_b32 m0, %2\n\ts_nop 0\n\tglobal_load_lds_dwordx4 %0, %1" : : "v"(voff), "s"(base), "s"(lds_dst) : "memory", "m0"); }

namespace pg8 {
constexpr int BM = 256, BK = 64, HALF = 128, HTB = HALF * BK * 2, STAGE_BYTES = 8 * HTB, NXCD = 8, WGM = 8;
__host__ __device__ __forceinline__ int lds_byte(int r, int c) { const int st = (r >> 4) * 2 + (c >> 5), rr = r & 15, cc = c & 31, ob = rr * 64 + cc * 2; return st * 1024 + (ob ^ (((ob >> 9) & 1) << 5)); }
__host__ __device__ __forceinline__ void stage_rc(int b, int& R, int& C) { const int st = b / 1024, sb = b % 1024, swz = sb ^ (((sb >> 9) & 1) << 5); R = (st >> 1) * 16 + swz / 64; C = (st & 1) * 32 + (swz % 64) / 2; }
__host__ __device__ __forceinline__ int perm32(int rho) { const int n = rho >> 4, i = rho & 15; return 8 * (i >> 2) + 4 * n + (i & 3); }
struct Unit { int pm, pn, k0, nk, sl; };
__device__ __forceinline__ bool order_next(int i, int G, int c, int nM, int nN, Unit& u) {
    const int nwg = nM * nN; const long L = (long)i * G + c; if (L >= nwg) return false;
    int wgid = (int)L; { const int q = nwg / NXCD, r = nwg % NXCD, xcd = wgid % NXCD, off = wgid / NXCD; wgid = (xcd < r ? xcd * (q + 1) : r * (q + 1) + (xcd - r) * q) + off; }
    const int nig = WGM * nN, gid = wgid / nig, fm = gid * WGM, gsz = (nM - fm) < WGM ? (nM - fm) : WGM;
    u.pm = fm + ((wgid % nig) % gsz); u.pn = (wgid % nig) / gsz; return true;
}
struct DenseSched {
    static constexpr bool GATHER = false, KSPLIT = false;
    int nM, nN, G, c; const char* A; const char* Bt; size_t tsA, tsB;
    __device__ __forceinline__ bool next(int i, Unit& u) const { return order_next(i, G, c, nM, nN, u); }
    __device__ __forceinline__ const char* a_base(const Unit& u) const { return A + (size_t)u.pm * tsA; }
    __device__ __forceinline__ const char* b_base(const Unit& u) const { return Bt + (size_t)u.pn * tsB; }
    __device__ __forceinline__ int a_row(const Unit&, int r) const { return r; }
    __device__ __forceinline__ const int* list_ptr(const Unit&, int) const { return nullptr; }
    __device__ __forceinline__ int a_row_lds(const Unit&, int r, const LAS unsigned*) const { return r; }
    __device__ __forceinline__ bool row_valid(const Unit&, int) const { return true; }
};
template <bool GATHER_> struct MoeSched {
    static constexpr bool GATHER = GATHER_, KSPLIT = false;
    int nM, nN, G, c; const char* A; const char* Bt; size_t tsA, tsB, esB; const LAS int* tab; const int* list; const float* glist;
    __device__ __forceinline__ bool next(int i, Unit& u) const { return order_next(i, G, c, nM, nN, u); }
    __device__ __forceinline__ const char* a_base(const Unit& u) const { return GATHER_ ? A : A + (size_t)u.pm * tsA; }
    __device__ __forceinline__ const char* b_base(const Unit& u) const { return Bt + (size_t)tab[u.pm] * esB + (size_t)u.pn * tsB; }
    __device__ __forceinline__ int a_row(const Unit& u, int r) const { const int e = tab[u.pm], lr = (u.pm - tab[272 + e]) * 256 + r; return lr < tab[288 + e] ? list[(size_t)e * T + lr] : 0; }
    __device__ __forceinline__ const int* list_ptr(const Unit& u, int r) const { const int e = tab[u.pm]; return list + (size_t)e * T + (u.pm - tab[272 + e]) * 256 + r; }
    __device__ __forceinline__ int a_row_lds(const Unit& u, int r, const LAS unsigned* lp) const { const int e = tab[u.pm], lr = (u.pm - tab[272 + e]) * 256 + r; const int v = (int)lp[r]; return lr < tab[288 + e] ? v : 0; }
    __device__ __forceinline__ const float* gate_ptr(const Unit& u, int r) const { const int e = tab[u.pm]; return glist + (size_t)e * T + (u.pm - tab[272 + e]) * 256 + r; }
    __device__ __forceinline__ bool row_valid(const Unit& u, int r) const { const int e = tab[u.pm]; return (u.pm - tab[272 + e]) * 256 + r < tab[288 + e]; }
    __device__ __forceinline__ float gate(const Unit& u, int r) const { const int e = tab[u.pm], lr = (u.pm - tab[272 + e]) * 256 + r; return lr < tab[288 + e] ? glist[(size_t)e * T + lr] : 0.f; }
};
constexpr int TAILR = 16 * 256;
__host__ __device__ __forceinline__ void moe_split(int nM, int nN, int G, int& nMf, int& R, int& SP) {
    if (G % nN != 0 || nM * nN / G < 1) { nMf = nM; R = 1 << 28; SP = 1; return; }
    R = nM * nN / G; nMf = R * (G / nN); const int ntail = (nM - nMf) * nN; SP = ntail * 8 <= G ? 8 : ntail * 4 <= G ? 4 : ntail * 2 <= G ? 2 : 1;
    if (nM - nMf > 16) { nMf = nM; R = 1 << 28; SP = 1; }
}
struct MoeDownSched : MoeSched<false> {
    static constexpr bool KSPLIT = true;
    int nMf, R, SP, NT;
    __device__ __forceinline__ bool next(int i, Unit& u) const {
        if (i < R) { const bool ok = order_next(i, G, c, nMf, nN, u); u.k0 = 0; u.nk = NT; u.sl = 0; return ok; }
        if (i > R) return false;
        const int ntail = (nM - nMf) * nN; if (c >= ntail * SP) return false;
        const int sh = SP == 8 ? 3 : SP == 4 ? 2 : SP == 2 ? 1 : 0, un = c >> sh, sl = c & (SP - 1), base = (NT / 2) >> sh, rem = (NT / 2) & (SP - 1);
        u.pm = __builtin_amdgcn_readfirstlane(nMf + (un >> 2)); u.pn = __builtin_amdgcn_readfirstlane(un & 3); u.k0 = __builtin_amdgcn_readfirstlane(2 * (sl * base + (sl < rem ? sl : rem)));
        u.nk = __builtin_amdgcn_readfirstlane(2 * (base + (sl < rem ? 1 : 0))); u.sl = __builtin_amdgcn_readfirstlane(sl); return true;
    }
    __device__ __forceinline__ const char* a_base(const Unit& u) const { return A + (size_t)u.pm * tsA + (size_t)u.k0 * 128; }
    __device__ __forceinline__ const char* b_base(const Unit& u) const { return Bt + (size_t)tab[u.pm] * esB + (size_t)u.pn * tsB + (size_t)u.k0 * 128; }
};

template <class Epi, class Sched, bool ALIGN_EPI, int MODE = 0, int EPI_VM = 0>
__device__ __forceinline__ void gemm_phase(LAS unsigned char* lds, const int KB, const Sched& S, const Epi& E) {
    constexpr bool FP8 = (MODE == 1);
    static_assert(ALIGN_EPI, "the pre-epilogue staging of the next unit's K-tile 1 assumes aligned epilogues");
    int tid_ = threadIdx.x; asm volatile("" : "+v"(tid_));
    const int tid = tid_, wid = __builtin_amdgcn_readfirstlane(tid >> 6), lane = tid & 63, wr = wid >> 2, wc = wid & 3, fr = lane & 15, fq = lane >> 4;
    const int nt = KB / 128;
    unsigned voffB[2];
#pragma unroll
    for (int i = 0; i < 2; ++i) { int R, C; stage_rc(tid * 16 + i * 8192, R, C); const int Rb = (R & ~31) + perm32(R & 31); voffB[i] = (unsigned)(Rb * KB + C * 2); }
    const size_t kstep = (size_t)(BK * 2);
    const size_t hstep = (size_t)HALF * KB;
    const unsigned ldsw = (unsigned)wid * 1024u; const unsigned lds0 = (unsigned)(uintptr_t)lds;
    const int aoff = lds_byte(wr * 64 + fr, fq * 8), boff = lds_byte(wc * 32 + fr, fq * 8);
#define PG8_SA(b, h) (((b) * 2 + (h)) * HTB)
#define PG8_SB(b, h) ((4 + (b) * 2 + (h)) * HTB)
#define PG8_STAGE(bufoff, gbase, voff) do { _Pragma("unroll") for (int _i = 0; _i < 2; ++_i) { \
        if constexpr (FP8) glds16s((const void*)(gbase), (voff)[_i], (unsigned)__builtin_amdgcn_readfirstlane((int)(lds0 + (unsigned)(bufoff) + ldsw + _i * 8192))); \
        else __builtin_amdgcn_global_load_lds((const unsigned*)((const char*)(gbase) + (voff)[_i]), (LAS unsigned*)(lds + (bufoff) + ldsw + _i * 8192), 16, 0, 0); } } while (0)
#define PG8_LD16(base, off) (*(const LAS v4i_t*)(size_t)((base) + (unsigned)(off)))
#define PG8_LD16B(base, off) (*(const LAS bf16x8*)(size_t)((base) + (unsigned)(off)))
#define PG8_LDA(dst, b, h) do { _Pragma("unroll") for (int m = 0; m < 4; ++m) { if constexpr (FP8) dst##8[m] = __builtin_shufflevector(PG8_LD16(ab, PG8_SA(b, h) + m * 2048), PG8_LD16(ab, PG8_SA(b, h) + m * 2048 + 1024), 0, 1, 2, 3, 4, 5, 6, 7); \
        else { _Pragma("unroll") for (int k = 0; k < 2; ++k) dst[m][k] = PG8_LD16B(ab, PG8_SA(b, h) + m * 2048 + k * 1024); } } } while (0)
#define PG8_LDB(dst, b, h) do { _Pragma("unroll") for (int n = 0; n < 2; ++n) { if constexpr (FP8) dst##8[n] = __builtin_shufflevector(PG8_LD16(bb, PG8_SB(b, h) + n * 2048), PG8_LD16(bb, PG8_SB(b, h) + n * 2048 + 1024), 0, 1, 2, 3, 4, 5, 6, 7); \
        else { _Pragma("unroll") for (int k = 0; k < 2; ++k) dst[n][k] = PG8_LD16B(bb, PG8_SB(b, h) + n * 2048 + k * 1024); } } } while (0)
#define PG8_MMA(ai, bj, At, Bt) do { __builtin_amdgcn_s_setprio(1); _Pragma("unroll") for (int m = 0; m < 4; ++m) _Pragma("unroll") for (int n = 0; n < 2; ++n) { \
        if constexpr (FP8) asm volatile("v_mfma_scale_f32_16x16x128_f8f6f4 %0, %1, %2, %0, %3, %3 op_sel_hi:[0,0,0]" : "+v"(acc[ai][bj][m][n]) : "v"(Bt##8[n]), "v"(At##8[m]), "v"(sc1)); \
        else if constexpr (MODE == 2) { _Pragma("unroll") for (int k = 0; k < 2; ++k) acc[ai][bj][m][n] = __builtin_bit_cast(f32x4, __builtin_amdgcn_mfma_i32_16x16x64_i8(__builtin_bit_cast(v4i_t, Bt[n][k]), __builtin_bit_cast(v4i_t, At[m][k]), __builtin_bit_cast(v4i_t, acc[ai][bj][m][n]), 0, 0, 0)); } \
        else { _Pragma("unroll") for (int k = 0; k < 2; ++k) acc[ai][bj][m][n] = __builtin_amdgcn_mfma_f32_16x16x32_bf16(Bt[n][k], At[m][k], acc[ai][bj][m][n], 0, 0, 0); } } \
        __builtin_amdgcn_s_setprio(0); } while (0)
#define PG8_WAIT_V(n) asm volatile("s_waitcnt vmcnt(" #n ")" ::: "memory")
#define PG8_WAIT_L(n) asm volatile("s_waitcnt lgkmcnt(" #n ")" ::: "memory")
#define PG8_WAIT_V1() do { static_assert(EPI_VM == 0 || EPI_VM == 8 || EPI_VM == 16, "EPI_VM"); if (EPI_VM == 8 && t == 0 && ui > 0) PG8_WAIT_V(16); else if (EPI_VM == 16 && t == 0 && ui > 0) PG8_WAIT_V(24); else PG8_WAIT_V(8); } while (0)
#define PG8_BAR __builtin_amdgcn_s_barrier()
#define PG8_SCHED __builtin_amdgcn_sched_barrier(0)
#define PG8_SETV(v, u, lp) do { int t2_ = threadIdx.x; asm volatile("" : "+v"(t2_)); _Pragma("unroll") for (int _i = 0; _i < 2; ++_i) { int R_, C_; stage_rc(t2_ * 16 + _i * 8192, R_, C_); \
        _Pragma("unroll") for (int _h = 0; _h < 2; ++_h) { const int row_ = Sched::GATHER ? S.a_row_lds(u, R_ + HALF * _h, lp) : (R_ + HALF * _h); v[_h][_i] = (unsigned)(row_ * KB + C_ * 2); } } } while (0)
    Unit cur, nxt; int ui = 0;
    if (!S.next(0, cur)) return;
    int ntc = nt; if constexpr (Sched::KSPLIT) ntc = cur.nk;
    f32x4 acc[2][2][4][2];
#pragma unroll
    for (int a = 0; a < 2; ++a)
#pragma unroll
        for (int b = 0; b < 2; ++b)
#pragma unroll
            for (int m = 0; m < 4; ++m)
#pragma unroll
                for (int n = 0; n < 2; ++n) acc[a][b][m][n] = (f32x4){0.f, 0.f, 0.f, 0.f};
    bf16x8 At[4][2], B0[2][2], B1[2][2]; v8i At8[4], B08[2], B18[2];
    int sc1 = 0x7f7f7f7f; asm volatile("" : "+v"(sc1));
    unsigned vA[2][2], vN[2][2];
#define PG8_LP(par) ((const LAS unsigned*)(lds + L_RS + (par) * RS_PAR + 2048))
    if constexpr (Sched::GATHER) { if (wid < 4) dma4(S.list_ptr(cur, tid), (LAS unsigned*)(lds + L_RS + 2048 + wid * 256)); PG8_WAIT_V(0); __syncthreads(); }
    PG8_SETV(vA, cur, PG8_LP(0));
#pragma unroll
    for (int h = 0; h < 2; ++h)
#pragma unroll
        for (int i = 0; i < 2; ++i) vN[h][i] = vA[h][i];
    const char* cA = S.a_base(cur); const char* cB = S.b_base(cur);
    PG8_STAGE(PG8_SB(0, 0), cB, voffB); PG8_STAGE(PG8_SB(0, 1), cB + hstep, voffB); PG8_STAGE(PG8_SA(0, 0), cA, vA[0]); PG8_STAGE(PG8_SA(0, 1), cA, vA[1]);
    if (wr == 1) PG8_BAR;
    PG8_WAIT_V(2); PG8_BAR;
    PG8_STAGE(PG8_SB(1, 0), cB + kstep, voffB); PG8_STAGE(PG8_SA(1, 0), cA + kstep, vA[0]); PG8_STAGE(PG8_SB(1, 1), cB + hstep + kstep, voffB);
    PG8_WAIT_V(6); PG8_BAR;
    for (;;) {
        const bool has_next = S.next(ui + 1, nxt);
        const char* nA = has_next ? S.a_base(nxt) : cA; const char* nB = has_next ? S.b_base(nxt) : cB;
        if constexpr (Sched::GATHER) { if (has_next && wid < 4) dma4(S.list_ptr(nxt, (int)threadIdx.x), (LAS unsigned*)(lds + L_RS + ((ui + 1) & 1) * RS_PAR + 2048 + wid * 256)); }
        if (Epi::HAS_RS && wid < 4) E.pf0(cur, S, (int)threadIdx.x, (LAS unsigned*)(lds + L_RS + (ui & 1) * RS_PAR + wid * 256));
#pragma unroll 1
        for (int t = 0; t < ntc; t += 2) {
            const bool last = (t == ntc - 2);
            unsigned ab = lds0 + (unsigned)aoff, bb = lds0 + (unsigned)boff; asm volatile("" : "+v"(ab), "+v"(bb));
            const char* a1 = cA + (size_t)(t + 1) * kstep;
            const char* a2 = last ? nA : cA + (size_t)(t + 2) * kstep; const char* b2 = last ? nB : cB + (size_t)(t + 2) * kstep;
            const char* a3 = a2 + kstep; const char* b3 = b2 + kstep;
            if constexpr (Sched::GATHER) { if (last && has_next) PG8_SETV(vN, nxt, PG8_LP((ui + 1) & 1)); }
            unsigned s0[2], s1[2];
#pragma unroll
            for (int i = 0; i < 2; ++i) { s0[i] = (Sched::GATHER && last) ? vN[0][i] : vA[0][i]; s1[i] = (Sched::GATHER && last) ? vN[1][i] : vA[1][i]; }
            PG8_LDB(B0, 0, 0); PG8_LDB(B1, 0, 1); PG8_SCHED; PG8_LDA(At, 0, 0); if (!(t == 0 && ui > 0)) PG8_STAGE(PG8_SA(1, 1), a1, vA[1]);
            PG8_WAIT_V1(); PG8_WAIT_L(0); PG8_BAR; PG8_MMA(0, 0, At, B0); PG8_MMA(0, 1, At, B1); PG8_BAR; PG8_SCHED;
            PG8_LDA(At, 0, 1); PG8_STAGE(PG8_SB(0, 0), b2, voffB); PG8_STAGE(PG8_SB(0, 1), b2 + hstep, voffB); PG8_STAGE(PG8_SA(0, 0), a2, s0);
            PG8_WAIT_V1(); PG8_WAIT_L(0); PG8_BAR; PG8_MMA(1, 0, At, B0); PG8_MMA(1, 1, At, B1); PG8_BAR; PG8_SCHED;
            PG8_LDB(B0, 1, 0); PG8_LDB(B1, 1, 1); PG8_SCHED; PG8_LDA(At, 1, 0); PG8_STAGE(PG8_SA(0, 1), a2, s1);
            PG8_WAIT_V1(); PG8_WAIT_L(0); PG8_BAR; PG8_MMA(0, 0, At, B0); PG8_MMA(0, 1, At, B1); PG8_BAR; PG8_SCHED;
            PG8_LDA(At, 1, 1); PG8_STAGE(PG8_SB(1, 0), b3, voffB); PG8_STAGE(PG8_SB(1, 1), b3 + hstep, voffB); PG8_STAGE(PG8_SA(1, 0), a3, s0);
            PG8_WAIT_V(8); PG8_WAIT_L(0); PG8_BAR; PG8_MMA(1, 0, At, B0); PG8_MMA(1, 1, At, B1); PG8_BAR; PG8_SCHED;
        }
        if constexpr (ALIGN_EPI) { if (wr == 0) PG8_BAR; }
        if constexpr (ALIGN_EPI) { if (has_next) { if constexpr (Sched::GATHER) PG8_STAGE(PG8_SA(1, 1), nA + kstep, vN[1]); else PG8_STAGE(PG8_SA(1, 1), nA + kstep, vA[1]); } }
        if constexpr (FP8) asm volatile("s_nop 15\n\ts_nop 15" ::: "memory");
        if constexpr (MODE == 2) {
#pragma unroll
            for (int a = 0; a < 2; ++a)
#pragma unroll
                for (int b = 0; b < 2; ++b)
#pragma unroll
                    for (int m = 0; m < 4; ++m)
#pragma unroll
                        for (int n = 0; n < 2; ++n) acc[a][b][m][n] = __builtin_convertvector(__builtin_bit_cast(v4i_t, acc[a][b][m][n]), f32x4); }
        { int t3_ = threadIdx.x; asm volatile("" : "+v"(t3_)); const int fr_ = t3_ & 15, fq_ = (t3_ & 63) >> 4;
          E(acc, cur, S, wr, wc, fr_, fq_, lds, (const LAS unsigned*)(lds + L_RS + (ui & 1) * RS_PAR)); }
        if (!has_next) break;
#pragma unroll
        for (int a = 0; a < 2; ++a)
#pragma unroll
            for (int b = 0; b < 2; ++b)
#pragma unroll
                for (int m = 0; m < 4; ++m)
#pragma unroll
                    for (int n = 0; n < 2; ++n) acc[a][b][m][n] = (f32x4){0.f, 0.f, 0.f, 0.f};
        cur = nxt; cA = nA; cB = nB; ++ui; if constexpr (Sched::KSPLIT) ntc = cur.nk;
        if constexpr (Sched::GATHER) {
#pragma unroll
            for (int h = 0; h < 2; ++h)
#pragma unroll
                for (int i = 0; i < 2; ++i) vA[h][i] = vN[h][i];
        }
        if constexpr (ALIGN_EPI) { if (wr == 1) PG8_BAR; }
    }
    PG8_WAIT_V(0);
    if constexpr (!ALIGN_EPI) { if (wr == 0) PG8_BAR; }
    PG8_BAR;
#undef PG8_SA
#undef PG8_SB
#undef PG8_STAGE
#undef PG8_LDA
#undef PG8_LDB
#undef PG8_MMA
#undef PG8_LD16
#undef PG8_LD16B
#undef PG8_WAIT_V
#undef PG8_WAIT_L
#undef PG8_WAIT_V1
#undef PG8_BAR
#undef PG8_SCHED
#undef PG8_SETV
#undef PG8_LP
}

#ifndef NT_EPI
#define NT_EPI 0
#endif
#if NT_EPI
#define NT_ST16(p, v) __builtin_nontemporal_store((v), (u32x4*)(p))
#else
#define NT_ST16(p, v) (*(u32x4*)(p) = (v))
#endif
__device__ __forceinline__ u32x4 pack8(const f32x4& v0, const f32x4& v1) { u32x4 w; w.x = cvt_pk_bf16(v0[0], v0[1]); w.y = cvt_pk_bf16(v0[2], v0[3]); w.z = cvt_pk_bf16(v1[0], v1[1]); w.w = cvt_pk_bf16(v1[2], v1[3]); return w; }

struct EpiNone { static constexpr bool HAS_RS = false; template <class Sched> __device__ __forceinline__ void pf0(const Unit&, const Sched&, int, LAS unsigned*) const {}
    template <class Sched> __device__ __forceinline__ void operator()(const f32x4 (&)[2][2][4][2], const Unit&, const Sched&, int, int, int, int, LAS unsigned char*, const LAS unsigned*) const {} };
template <bool NOSS = false> struct EpiQKV0T {
    bf16* Q; bf16* Kb; bf16* Vb; const u64* ss; float qscale;
    static constexpr bool HAS_RS = !NOSS;
    template <class Sched> __device__ __forceinline__ void pf0(const Unit& u, const Sched&, int tid, LAS unsigned* l) const { const unsigned* p = (const unsigned*)(ss + u.pm * 256 + tid); dma4(p, l); dma4(p + 1, l + 256); }
    template <class Sched> __device__ __forceinline__ void operator()(const f32x4 (&acc)[2][2][4][2], const Unit& u, const Sched&, int wr, int wc, int fr, int fq, LAS unsigned char*, const LAS unsigned* RS) const {
        const int sect = u.pn >> 2, colt = (u.pn & 3) * 256 + wc * 32 + 8 * fq;
#pragma unroll
        for (int ai = 0; ai < 2; ++ai)
#pragma unroll
            for (int m = 0; m < 4; ++m) {
                const int row = u.pm * 256 + ai * 128 + wr * 64 + m * 16 + fr;
                float rs = NOSS ? 1.f : rs_from_planes(RS, ai * 128 + wr * 64 + m * 16 + fr); if (sect == 0) rs *= qscale;
                bf16* dst = (sect == 0) ? Q + (size_t)row * DM : ((sect == 1) ? Kb : Vb) + ((size_t)(row >> 11) * KROWS + 64 + (row & 2047)) * DM;
#pragma unroll
                for (int bj = 0; bj < 2; ++bj) *(u32x4*)(dst + colt + bj * HALF) = pack8(acc[ai][bj][m][0] * rs, acc[ai][bj][m][1] * rs);
            }
    }
};
typedef EpiQKV0T<false> EpiQKV0;
struct EpiQKV0I8 {
    bf16* Q; bf16* Kb; bf16* Vb; const float* ra; const unsigned* cmax; float qscale;
    static constexpr bool HAS_RS = true;
    template <class Sched> __device__ __forceinline__ void pf0(const Unit& u, const Sched&, int tid, LAS unsigned* l) const { dma4(ra + u.pm * 256 + tid, l); dma4(cmax + u.pn * 256 + tid, l + 1024); }
    template <class Sched> __device__ __forceinline__ void operator()(const f32x4 (&acc)[2][2][4][2], const Unit& u, const Sched&, int wr, int wc, int fr, int fq, LAS unsigned char*, const LAS unsigned* RS) const {
        const int sect = u.pn >> 2, colt = (u.pn & 3) * 256 + wc * 32 + 8 * fq;
        const LAS unsigned* cm = RS + 1024 + wc * 32 + 8 * fq; const float cs = (sect == 0 ? qscale : 1.f) * (1.f / 127.f);
        f32x4 sb[2][2];
#pragma unroll
        for (int bj = 0; bj < 2; ++bj)
#pragma unroll
            for (int n = 0; n < 2; ++n) sb[bj][n] = __builtin_bit_cast(f32x4, *(const LAS u32x4*)(cm + bj * 128 + 4 * n)) * cs;
#pragma unroll
        for (int ai = 0; ai < 2; ++ai)
#pragma unroll
            for (int m = 0; m < 4; ++m) {
                const int lrow = ai * 128 + wr * 64 + m * 16 + fr, row = u.pm * 256 + lrow;
                const float rs = __builtin_bit_cast(float, RS[lrow]);
                bf16* dst = (sect == 0) ? Q + (size_t)row * DM : ((sect == 1) ? Kb : Vb) + ((size_t)(row >> 11) * KROWS + 64 + (row & 2047)) * DM;
#pragma unroll
                for (int bj = 0; bj < 2; ++bj) NT_ST16(dst + colt + bj * HALF, pack8(acc[ai][bj][m][0] * (sb[bj][0] * rs), acc[ai][bj][m][1] * (sb[bj][1] * rs)));
            }
    }
};
template <int QM = 0, bool DS = false, bool SK = false> struct EpiResidT {
    bf16* h; u64* ss; unsigned char* h8; bf16* hout; const u64* ssp = nullptr; float dsc = 1.f; const bf16* skw = nullptr; int* pl = nullptr;
    static constexpr bool HAS_RS = (QM == 2);
    template <class Sched> __device__ __forceinline__ void pf0(const Unit& u, const Sched&, int tid, LAS unsigned* l) const { if constexpr (QM == 2) { const unsigned* p = (const unsigned*)(ssp + u.pm * 256 + tid); dma4(p, l); dma4(p + 1, l + 256); } }
    template <class Sched> __device__ __forceinline__ void operator()(const f32x4 (&acc)[2][2][4][2], const Unit& u, const Sched&, int wr, int wc, int fr, int fq, LAS unsigned char* lds, const LAS unsigned* RS) const {
        const int col = u.pn * 256 + wc * 32 + 8 * fq;
        bf16x8 wf[2]; const int t8 = ((wr * 4 + wc) * 64 + fq * 16 + fr) * 8;
        if constexpr (SK) {
            LAS u32x4* z = (LAS u32x4*)(lds + (t8 < 2048 ? L_X + t8 * 4 : L_LG2 + (t8 - 2048) * 4)); z[0] = (u32x4){0u, 0u, 0u, 0u}; z[1] = (u32x4){0u, 0u, 0u, 0u};
#pragma unroll
            for (int bj = 0; bj < 2; ++bj) wf[bj] = *(const bf16x8*)(skw + (size_t)fr * DM + col + bj * HALF);
            asm volatile("s_waitcnt lgkmcnt(0)\n\ts_barrier" ::: "memory");
        }
#pragma unroll
        for (int ai = 0; ai < 2; ++ai) {
            u32x4 hv[4][2];
#pragma unroll
            for (int m = 0; m < 4; ++m)
#pragma unroll
                for (int bj = 0; bj < 2; ++bj) hv[m][bj] = *(const u32x4*)(h + (size_t)(u.pm * 256 + ai * 128 + wr * 64 + m * 16 + fr) * DM + col + bj * HALF);
            float sq[4];
#pragma unroll
            for (int m = 0; m < 4; ++m) {
                const int row = u.pm * 256 + ai * 128 + wr * 64 + m * 16 + fr; float s = 0.f; f32x4 lg = {0.f, 0.f, 0.f, 0.f};
                float qi = 0.f; if constexpr (QM == 2) qi = frsq(ms_from_planes(RS, ai * 128 + wr * 64 + m * 16 + fr)) * (127.f / CQ);
#pragma unroll
                for (int bj = 0; bj < 2; ++bj) {
                    const u32x4 o = hv[m][bj];
                    f32x4 v0 = acc[ai][bj][m][0], v1 = acc[ai][bj][m][1]; if constexpr (DS) { v0 = v0 * dsc; v1 = v1 * dsc; }
                    v0[0] += bflo(o.x); v0[1] += bfhi(o.x); v0[2] += bflo(o.y); v0[3] += bfhi(o.y); v1[0] += bflo(o.z); v1[1] += bfhi(o.z); v1[2] += bflo(o.w); v1[3] += bfhi(o.w);
                    s += (v0[0] * v0[0] + v0[1] * v0[1]) + (v0[2] * v0[2] + v0[3] * v0[3]) + (v1[0] * v1[0] + v1[1] * v1[1]) + (v1[2] * v1[2] + v1[3] * v1[3]);
                    const u32x4 pk = pack8(v0, v1); *(u32x4*)(hout + (size_t)row * DM + col + bj * HALF) = pk;
                    if constexpr (SK) lg = __builtin_amdgcn_mfma_f32_16x16x32_bf16(wf[bj], __builtin_bit_cast(bf16x8, pk), lg, 0, 0, 0);
                    if constexpr (QM == 1) { u32x2 q; q.x = pk4_fp8(v0[0] * QS_H, v0[1] * QS_H, v0[2] * QS_H, v0[3] * QS_H); q.y = pk4_fp8(v1[0] * QS_H, v1[1] * QS_H, v1[2] * QS_H, v1[3] * QS_H); *(u32x2*)(h8 + (size_t)row * DM + col + bj * HALF) = q; }
                    if constexpr (QM == 2) { u32x2 q; q.x = pk4_i8(v0[0] * qi, v0[1] * qi, v0[2] * qi, v0[3] * qi); q.y = pk4_i8(v1[0] * qi, v1[1] * qi, v1[2] * qi, v1[3] * qi); *(u32x2*)(h8 + (size_t)row * DM + col + bj * HALF) = q; }
                }
                s += __shfl_xor(s, 16); s += __shfl_xor(s, 32); sq[m] = s;
                if constexpr (SK) { LAS int* lgp = (LAS int*)(lds + (ai ? L_LG2 : L_X)) + (wr * 64 + m * 16 + fr) * 16 + 4 * fq;
#pragma unroll
                    for (int i = 0; i < 4; ++i) __hip_atomic_fetch_add(lgp + i, (int)__builtin_rintf(lg[i] * PLS), __ATOMIC_RELAXED, __HIP_MEMORY_SCOPE_WORKGROUP); }
            }
            const float val = fq == 0 ? sq[0] : fq == 1 ? sq[1] : fq == 2 ? sq[2] : sq[3];
            atomicAdd(ss + u.pm * 256 + ai * 128 + wr * 64 + fq * 16 + fr, to_fx(val));
        }
        if constexpr (SK) {
            asm volatile("s_waitcnt lgkmcnt(0)\n\ts_barrier" ::: "memory");
            const LAS u32x4* z = (const LAS u32x4*)(lds + (t8 < 2048 ? L_X + t8 * 4 : L_LG2 + (t8 - 2048) * 4)); const u32x4 a = z[0], b = z[1];
            u32x4* dst = (u32x4*)(pl + ((size_t)(u.pm * 256 + (t8 >> 4)) * 4 + u.pn) * 16 + (t8 & 8)); dst[0] = a; dst[1] = b;
        }
    }
};
typedef EpiResidT<0> EpiResid;
template <bool MOE> struct EpiSwiglu {
    bf16* act; const u64* ss;
    static constexpr bool HAS_RS = true;
    template <class Sched> __device__ __forceinline__ void pf0(const Unit& u, const Sched& S, int tid, LAS unsigned* l) const {
        const int srow = MOE ? S.a_row_lds(u, tid, l + 512 - (tid >> 6) * 64) : u.pm * 256 + tid; const unsigned* p = (const unsigned*)(ss + srow); dma4(p, l); dma4(p + 1, l + 256); }
    template <class Sched> __device__ __forceinline__ void operator()(const f32x4 (&acc)[2][2][4][2], const Unit& u, const Sched& S, int wr, int wc, int fr, int fq, LAS unsigned char*, const LAS unsigned* RS) const {
        const int col = u.pn * 128 + wc * 32 + 8 * fq;
#pragma unroll
        for (int ai = 0; ai < 2; ++ai)
#pragma unroll
            for (int m = 0; m < 4; ++m) {
                const int lrow = ai * 128 + wr * 64 + m * 16 + fr, orow = u.pm * 256 + lrow;
                float rs = 0.f; if constexpr (!MOE) rs = rs_from_planes(RS, lrow);
                const float rq = MOE ? rs * (1.f / (QS_H * QS_WGU)) : rs; const float c1 = MOE ? __builtin_bit_cast(float, RS[lrow]) : -rq * LOG2E, k2 = MOE ? __builtin_bit_cast(float, RS[256 + lrow]) : frcp(rq * rq);
                f32x4 o[2];
#pragma unroll
                for (int n = 0; n < 2; ++n)
#pragma unroll
                    for (int i = 0; i < 4; i += 2) { const f32x2 g = {acc[ai][0][m][n][i], acc[ai][0][m][n][i + 1]}, uu = {acc[ai][1][m][n][i], acc[ai][1][m][n][i + 1]};
                        const f32x2 a = g * c1; f32x2 e; e.x = fexp2(a.x); e.y = fexp2(a.y); const f32x2 kk = {k2, k2}, d = __builtin_elementwise_fma(e, kk, kk); f32x2 r; r.x = frcp(d.x); r.y = frcp(d.y);
                        f32x2 v = (g * uu) * r; if constexpr (MOE) { v.x = clamp8(v.x); v.y = clamp8(v.y); } o[n][i] = v.x; o[n][i + 1] = v.y; }
                if constexpr (MOE) { u32x2 q; int p0 = __builtin_amdgcn_cvt_pk_fp8_f32(o[0][0], o[0][1], __builtin_bit_cast(int, o[0][0]), false); p0 = __builtin_amdgcn_cvt_pk_fp8_f32(o[0][2], o[0][3], p0, true);
                    int p1 = __builtin_amdgcn_cvt_pk_fp8_f32(o[1][0], o[1][1], __builtin_bit_cast(int, o[1][0]), false); p1 = __builtin_amdgcn_cvt_pk_fp8_f32(o[1][2], o[1][3], p1, true); q.x = (unsigned)p0; q.y = (unsigned)p1;
                    *(u32x2*)((unsigned char*)act + (size_t)orow * FF + col) = q; }
                else *(u32x4*)(act + (size_t)orow * FF + col) = pack8(o[0], o[1]);
            }
    }
};
template <bool F8OUT> struct EpiSwigluI8T {
    bf16* act; const u64* ss; const u64* ssp; const unsigned* cmax;
    static constexpr bool HAS_RS = true;
    template <class Sched> __device__ __forceinline__ void pf0(const Unit& u, const Sched&, int tid, LAS unsigned* l) const {
        const unsigned* p = (const unsigned*)(ss + u.pm * 256 + tid); dma4(p, l); dma4(p + 1, l + 256); const unsigned* p2 = (const unsigned*)(ssp + u.pm * 256 + tid); dma4(p2, l + 512); dma4(p2 + 1, l + 768); dma4(cmax + u.pn * 256 + tid, l + 1024); }
    template <class Sched> __device__ __forceinline__ void operator()(const f32x4 (&acc)[2][2][4][2], const Unit& u, const Sched&, int wr, int wc, int fr, int fq, LAS unsigned char*, const LAS unsigned* RS) const {
        const int col = u.pn * 128 + wc * 32 + 8 * fq;
        const LAS unsigned* cm = RS + 1024 + wc * 32 + 8 * fq;
        f32x4 sg[2], su[2];
#pragma unroll
        for (int n = 0; n < 2; ++n) { const u32x4 a = *(const LAS u32x4*)(cm + 4 * n), b = *(const LAS u32x4*)(cm + 128 + 4 * n);
            sg[n] = __builtin_bit_cast(f32x4, a) * (1.f / 127.f); su[n] = __builtin_bit_cast(f32x4, b) * (1.f / 127.f); }
        float c1s[2], k2s[2];
#pragma unroll
        for (int j = 0; j < 2; ++j) { const int k = 2 * fq + j, lr = (k >> 2) * 128 + wr * 64 + (k & 3) * 16 + fr;
            const float rs = rs_from_planes(RS, lr), msp = ms_from_planes(RS + 512, lr), rq = rs * (msp * frsq(msp)) * (CQ / 127.f);
            c1s[j] = -rq * LOG2E; k2s[j] = frcp(rq * rq * (F8OUT ? QS_ACT : 1.f)); }
#pragma unroll
        for (int ai = 0; ai < 2; ++ai)
#pragma unroll
            for (int m = 0; m < 4; ++m) {
                const int lrow = ai * 128 + wr * 64 + m * 16 + fr, orow = u.pm * 256 + lrow;
                const int kk_ = ai * 4 + m, src_ = fr + 16 * (kk_ >> 1);
                const float c1 = __shfl(c1s[kk_ & 1], src_), k2 = __shfl(k2s[kk_ & 1], src_);
                f32x4 o[2];
#pragma unroll
                for (int n = 0; n < 2; ++n)
#pragma unroll
                    for (int i = 0; i < 4; i += 2) {
                        f32x2 g = {acc[ai][0][m][n][i], acc[ai][0][m][n][i + 1]}, uu = {acc[ai][1][m][n][i], acc[ai][1][m][n][i + 1]};
                        g = g * (f32x2){sg[n][i], sg[n][i + 1]}; uu = uu * (f32x2){su[n][i], su[n][i + 1]};
                        const f32x2 a = g * c1; f32x2 e; e.x = fexp2(a.x); e.y = fexp2(a.y); const f32x2 kk = {k2, k2}, d = __builtin_elementwise_fma(e, kk, kk); f32x2 r; r.x = frcp(d.x); r.y = frcp(d.y);
                        f32x2 v = (g * uu) * r; o[n][i] = v.x; o[n][i + 1] = v.y; }
                if constexpr (F8OUT) { u32x2 q; q.x = pk4_fp8(o[0][0], o[0][1], o[0][2], o[0][3]); q.y = pk4_fp8(o[1][0], o[1][1], o[1][2], o[1][3]); *(u32x2*)((unsigned char*)act + (size_t)orow * FF + col) = q; }
                else *(u32x4*)(act + (size_t)orow * FF + col) = pack8(o[0], o[1]);
            }
    }
};
typedef EpiSwigluI8T<false> EpiSwigluI8;
template <bool I8> struct EpiHeadNormT {
    bf16* Q; bf16* Kb; bf16* Vb; const u64* ss; const float* qn; const float* kn; float descale; const u64* ssp = nullptr; const unsigned* cmax = nullptr;
    static constexpr bool HAS_RS = true;
    template <class Sched> __device__ __forceinline__ void pf0(const Unit& u, const Sched&, int tid, LAS unsigned* l) const { const unsigned* p = (const unsigned*)(ss + u.pm * 256 + tid); dma4(p, l); dma4(p + 1, l + 256);
        if constexpr (I8) { const unsigned* p2 = (const unsigned*)(ssp + u.pm * 256 + tid); dma4(p2, l + 512); dma4(p2 + 1, l + 768); dma4(cmax + u.pn * 256 + tid, l + 1024); } }
    template <class Sched> __device__ __forceinline__ void operator()(const f32x4 (&accr)[2][2][4][2], const Unit& u, const Sched&, int wr, int wc, int fr, int fq, LAS unsigned char* lds, const LAS unsigned* RS) const {
        const int sect = u.pn >> 2, colt = (u.pn & 3) * 256 + wc * 32 + 8 * fq;
        f32x4 sb[2][2];
        if constexpr (I8) { const LAS unsigned* cm = RS + 1024 + wc * 32 + 8 * fq;
#pragma unroll
            for (int bj = 0; bj < 2; ++bj)
#pragma unroll
                for (int n = 0; n < 2; ++n) sb[bj][n] = __builtin_bit_cast(f32x4, *(const LAS u32x4*)(cm + bj * 128 + 4 * n)) * (1.f / 127.f); }
        float rs[2][4];
#pragma unroll
        for (int ai = 0; ai < 2; ++ai)
#pragma unroll
            for (int m = 0; m < 4; ++m) { const int lr = ai * 128 + wr * 64 + m * 16 + fr;
                if constexpr (I8) { const float msp = ms_from_planes(RS + 512, lr); rs[ai][m] = rs_from_planes(RS, lr) * (msp * frsq(msp)) * (CQ / 127.f); } else rs[ai][m] = rs_from_planes(RS, lr) * descale; }
        if (sect == 2) {
#pragma unroll
            for (int ai = 0; ai < 2; ++ai)
#pragma unroll
                for (int m = 0; m < 4; ++m) { const int row = u.pm * 256 + ai * 128 + wr * 64 + m * 16 + fr; bf16* dst = Vb + ((size_t)(row >> 11) * KROWS + 64 + (row & 2047)) * DM;
#pragma unroll
                    for (int bj = 0; bj < 2; ++bj) NT_ST16(dst + colt + bj * HALF, pack8(accr[ai][bj][m][0] * (I8 ? sb[bj][0] * rs[ai][m] : (f32x4){rs[ai][m], rs[ai][m], rs[ai][m], rs[ai][m]}), accr[ai][bj][m][1] * (I8 ? sb[bj][1] * rs[ai][m] : (f32x4){rs[ai][m], rs[ai][m], rs[ai][m], rs[ai][m]}))); }
            return;
        }
        LAS float* X = (LAS float*)(lds + L_X);
        float part[2][2][4];
#pragma unroll
        for (int ai = 0; ai < 2; ++ai)
#pragma unroll
            for (int bj = 0; bj < 2; ++bj)
#pragma unroll
                for (int m = 0; m < 4; ++m) { f32x4 v0, v1; if constexpr (I8) { v0 = accr[ai][bj][m][0] * (sb[bj][0] * rs[ai][m]); v1 = accr[ai][bj][m][1] * (sb[bj][1] * rs[ai][m]); } else { v0 = accr[ai][bj][m][0] * rs[ai][m]; v1 = accr[ai][bj][m][1] * rs[ai][m]; }
                    float s = (v0[0] * v0[0] + v0[1] * v0[1]) + (v0[2] * v0[2] + v0[3] * v0[3]) + (v1[0] * v1[0] + v1[1] * v1[1]) + (v1[2] * v1[2] + v1[3] * v1[3]);
                    s += __shfl_xor(s, 16); s += __shfl_xor(s, 32); part[ai][bj][m] = s;
                    if (fq == 0) X[((ai * 128 + wr * 64 + m * 16 + fr) * 2 + bj) * 4 + wc] = s; }
        asm volatile("s_waitcnt lgkmcnt(0)\n\ts_barrier" ::: "memory");
        const float* gp = (sect == 0 ? qn : kn) + (wc & 1) * 32 + 8 * fq; const float gsc = sect == 0 ? C2 : 1.f;
        f32x4 g0 = *(const f32x4*)gp * gsc, g1 = *(const f32x4*)(gp + 4) * gsc;
#pragma unroll
        for (int ai = 0; ai < 2; ++ai)
#pragma unroll
            for (int m = 0; m < 4; ++m) { const int row = u.pm * 256 + ai * 128 + wr * 64 + m * 16 + fr;
                bf16* dst = (sect == 0) ? Q + (size_t)row * DM : Kb + ((size_t)(row >> 11) * KROWS + 64 + (row & 2047)) * DM;
#pragma unroll
                for (int bj = 0; bj < 2; ++bj) { const float tot = part[ai][bj][m] + X[((ai * 128 + wr * 64 + m * 16 + fr) * 2 + bj) * 4 + (wc ^ 1)];
                    const float hs = frsq(tot * (1.f / HD) + EPS) * rs[ai][m];
                    if constexpr (I8) NT_ST16(dst + colt + bj * HALF, pack8(accr[ai][bj][m][0] * (hs * (sb[bj][0] * g0)), accr[ai][bj][m][1] * (hs * (sb[bj][1] * g1))));
                    else *(u32x4*)(dst + colt + bj * HALF) = pack8(accr[ai][bj][m][0] * hs * g0, accr[ai][bj][m][1] * hs * g1); } }
    }
};
typedef EpiHeadNormT<false> EpiHeadNorm;
struct EpiHeadNormI8W {
    bf16* Q; bf16* Kb; bf16* Vb; const u64* ss; const float* qn; const float* kn; const u64* ssp; const unsigned* cmax;
    static constexpr bool HAS_RS = true;
    template <class Sched> __device__ __forceinline__ void pf0(const Unit& u, const Sched&, int tid, LAS unsigned* l) const { const unsigned* p = (const unsigned*)(ss + u.pm * 256 + tid); dma4(p, l); dma4(p + 1, l + 256);
        const unsigned* p2 = (const unsigned*)(ssp + u.pm * 256 + tid); dma4(p2, l + 512); dma4(p2 + 1, l + 768); dma4(cmax + u.pn * 256 + tid, l + 1024); }
    template <class Sched> __device__ __forceinline__ void operator()(const f32x4 (&acc)[2][2][4][2], const Unit& u, const Sched&, int wr, int wc, int fr, int fq, LAS unsigned char* lds, const LAS unsigned* RS) const {
        const int sect = u.pn >> 2, colt = (u.pn & 3) * 256 + wc * 64 + 8 * fq;
        const LAS unsigned* cm = RS + 1024 + wc * 64 + 8 * fq;
        f32x4 sb[2][2];
#pragma unroll
        for (int bj = 0; bj < 2; ++bj)
#pragma unroll
            for (int n = 0; n < 2; ++n) sb[bj][n] = __builtin_bit_cast(f32x4, *(const LAS u32x4*)(cm + bj * 32 + 4 * n)) * (1.f / 127.f);
        f32x4 sbg[2][2];
        { const LAS float* gp = (const LAS float*)(lds + L_X) + (sect == 1 ? 64 : 0) + 8 * fq; const float gsc = sect == 0 ? C2 : 1.f; f32x4 gv[2][2];
#pragma unroll
            for (int bj = 0; bj < 2; ++bj)
#pragma unroll
                for (int n = 0; n < 2; ++n) gv[bj][n] = *(const LAS f32x4*)(gp + bj * 32 + 4 * n);
#pragma unroll
            for (int bj = 0; bj < 2; ++bj)
#pragma unroll
                for (int n = 0; n < 2; ++n) { const f32x4 gg = sb[bj][n] * (gv[bj][n] * gsc); sbg[bj][n] = (sect < 2) ? gg : sb[bj][n]; } }
        float rss[2];
#pragma unroll
        for (int j = 0; j < 2; ++j) { const int k = 2 * fq + j, lr = (k >> 2) * 128 + wr * 64 + (k & 3) * 16 + fr;
            const float msp = ms_from_planes(RS + 512, lr); rss[j] = rs_from_planes(RS, lr) * (msp * frsq(msp)) * (CQ / 127.f); }
#pragma unroll
        for (int ai = 0; ai < 2; ++ai)
#pragma unroll
            for (int m = 0; m < 4; ++m) { const int lr = ai * 128 + wr * 64 + m * 16 + fr, row = u.pm * 256 + lr;
                const int kk_ = ai * 4 + m; const float rs = __shfl(rss[kk_ & 1], fr + 16 * (kk_ >> 1));
                float hs = rs;
                if (sect < 2) { float s = 0.f;
#pragma unroll
                    for (int bj = 0; bj < 2; ++bj)
#pragma unroll
                        for (int n = 0; n < 2; ++n) { const f32x4 t = acc[ai][bj][m][n] * sb[bj][n]; s += (t[0] * t[0] + t[1] * t[1]) + (t[2] * t[2] + t[3] * t[3]); }
                    s += __shfl_xor(s, 16); s += __shfl_xor(s, 32);
                    hs = frsq(s * (rs * rs) * (1.f / HD) + EPS) * rs; }
                bf16* dst = (sect == 0) ? Q + (size_t)row * DM : ((sect == 1) ? Kb : Vb) + ((size_t)(row >> 11) * KROWS + 64 + (row & 2047)) * DM;
#pragma unroll
                for (int bj = 0; bj < 2; ++bj) *(u32x4*)(dst + colt + bj * 32) = pack8(acc[ai][bj][m][0] * (sbg[bj][0] * hs), acc[ai][bj][m][1] * (sbg[bj][1] * hs)); }
    }
};
struct EpiMoE2 {
    bf16* C; bf16* CP; int nMf;
    static constexpr bool HAS_RS = true;
    template <class Sched> __device__ __forceinline__ void pf0(const Unit& u, const Sched& S, int tid, LAS unsigned* l) const { dma4(S.gate_ptr(u, tid), l); }
    template <class Sched> __device__ __forceinline__ void operator()(const f32x4 (&acc)[2][2][4][2], const Unit& u, const Sched& S, int wr, int wc, int fr, int fq, LAS unsigned char*, const LAS unsigned* RS) const {
        const int col = u.pn * 256 + wc * 32 + 8 * fq;
#pragma unroll
        for (int ai = 0; ai < 2; ++ai)
#pragma unroll
            for (int m = 0; m < 4; ++m) { const int lrow = ai * 128 + wr * 64 + m * 16 + fr; const float gt = __builtin_bit_cast(float, RS[lrow]) * (1.f / (QS_ACT * QS_WDN)); bf16* dst = (u.sl == 0 ? C + (size_t)u.pm * 256 * DM : CP + ((size_t)(u.sl - 1) * TAILR + (size_t)(u.pm - nMf) * 256) * DM) + (size_t)lrow * DM + col;
#pragma unroll
                for (int bj = 0; bj < 2; ++bj) *(u32x4*)(dst + bj * HALF) = pack8(acc[ai][bj][m][0] * gt, acc[ai][bj][m][1] * gt); }
    }
};
}
namespace att {
constexpr int A_K = 0, A_V = 16384, A_WS = 32768, A_OST = 34816, A_NB = 67584, A_FLAG = 76288, A_SCAN = 76416, A_END = 76544;
static_assert(A_NB + KROWS * 4 <= A_FLAG && A_END <= RING_BYTES, "attention lds map");
__device__ __forceinline__ int crow(int r, int hi) { return (r & 3) + 8 * (r >> 2) + 4 * hi; }
__device__ __forceinline__ void glds16(const void* gsrc, unsigned lds_dst) { unsigned keep;
    asm volatile("s_mov_b32 %0, m0\n\ts_mov_b32 m0, %2\n\ts_nop 0\n\tglobal_load_lds_dwordx4 %1, off\n\ts_mov_b32 m0, %0" : "=&s"(keep) : "v"(gsrc), "s"(lds_dst) : "memory"); }
#define ATT_WAIT_BAR(N) asm volatile("s_waitcnt vmcnt(" #N ") lgkmcnt(0)\n\ts_barrier" ::: "memory")
__device__ __forceinline__ void qkt(f32x16& p0, f32x16& p1, const LAS unsigned char* Kslot, const bf16x8* qr, const f32x16& cinit, int r32, int hi) {
    const LAS unsigned char* kb = Kslot + hi * 1024 + r32 * 16;
#pragma unroll
    for (int d0 = 0; d0 < 4; ++d0) {
        const bf16x8 b0 = *(const LAS bf16x8*)(kb + d0 * 2048);
        const bf16x8 b1 = *(const LAS bf16x8*)(kb + d0 * 2048 + 512);
        if (d0 == 0) { p0 = __builtin_amdgcn_mfma_f32_32x32x16_bf16(b0, qr[0], cinit, 0, 0, 0); p1 = __builtin_amdgcn_mfma_f32_32x32x16_bf16(b1, qr[0], cinit, 0, 0, 0); }
        else { p0 = __builtin_amdgcn_mfma_f32_32x32x16_bf16(b0, qr[d0], p0, 0, 0, 0); p1 = __builtin_amdgcn_mfma_f32_32x32x16_bf16(b1, qr[d0], p1, 0, 0, 0); } }
}
__device__ __forceinline__ void pv(f32x16* o, int vb, bf16x8 pa0, bf16x8 pa1, bf16x8 pa2, bf16x8 pa3) {
#pragma unroll
    for (int d0 = 0; d0 < 2; ++d0) { s16x4 lo[4], hi[4];
#pragma unroll
        for (int ks = 0; ks < 4; ++ks) {
            asm volatile("ds_read_b64_tr_b16 %0,%1 offset:%c2" : "=&v"(lo[ks]) : "v"(vb), "i"(d0 * 4096 + ks * 1024) : "memory");
            asm volatile("ds_read_b64_tr_b16 %0,%1 offset:%c2" : "=&v"(hi[ks]) : "v"(vb), "i"(d0 * 4096 + ks * 1024 + 512) : "memory"); }
        asm volatile("s_waitcnt lgkmcnt(0)" ::: "memory"); __builtin_amdgcn_sched_barrier(0);
#define ATT_PK(k) (bf16x8){lo[k][0], lo[k][1], lo[k][2], lo[k][3], hi[k][0], hi[k][1], hi[k][2], hi[k][3]}
        o[d0] = __builtin_amdgcn_mfma_f32_32x32x16_bf16(pa0, ATT_PK(0), o[d0], 0, 0, 0);
        o[d0] = __builtin_amdgcn_mfma_f32_32x32x16_bf16(pa1, ATT_PK(1), o[d0], 0, 0, 0);
        o[d0] = __builtin_amdgcn_mfma_f32_32x32x16_bf16(pa2, ATT_PK(2), o[d0], 0, 0, 0);
        o[d0] = __builtin_amdgcn_mfma_f32_32x32x16_bf16(pa3, ATT_PK(3), o[d0], 0, 0, 0);
#undef ATT_PK
    }
}
__device__ __forceinline__ float swap_lo(float v, float& other_hi) { auto rr = __builtin_amdgcn_permlane32_swap(__float_as_uint(v), __float_as_uint(v), false, false); other_hi = __uint_as_float(rr[1]); return __uint_as_float(rr[0]); }

template <int MODE>
__device__ __forceinline__ void attn_unit(int b, int h, int qb, const bf16* Q, const bf16* __restrict__ K, const bf16* __restrict__ V, bf16* O, LAS unsigned char* shm) {
    int tid_ = threadIdx.x; asm volatile("" : "+v"(tid_));
    const int tid = tid_, lane = tid & 63, r32 = lane & 31, hi = lane >> 5; const int wid = __builtin_amdgcn_readfirstlane(tid >> 6);
    const bf16* Qw = Q + ((size_t)b * SEQ + qb * 256 + wid * 32) * DM + h * HD;
    const bf16* Kh = K + (size_t)b * KROWS * DM + h * HD; const bf16* Vh = V + (size_t)b * KROWS * DM + h * HD;
    const unsigned lds0 = (unsigned)(uintptr_t)shm;
    LAS float* wsf = (LAS float*)(shm + A_WS) + wid * 64;
    const bf16* ksrc = Kh + (size_t)lane * DM + wid * 8;
    const bf16* vsrc = Vh + (size_t)(16 * (wid & 3) + (lane >> 2)) * DM + (wid >> 2) * 32 + (lane & 3) * 8;
    const unsigned kdst = lds0 + A_K + wid * 1024, vdst = lds0 + A_V + wid * 1024;
#define ATT_DMA_K(t, slot) glds16(ksrc + (size_t)(t) * 64 * DM, (unsigned)__builtin_amdgcn_readfirstlane(kdst + (slot)))
#define ATT_DMA_V(t, slot) glds16(vsrc + (size_t)(t) * 64 * DM, (unsigned)__builtin_amdgcn_readfirstlane(vdst + (slot)))
    const int vb0 = (int)(lds0 + A_V) + ((lane >> 4) & 1) * 32 + (lane & 3) * 8 + (4 * hi + ((lane & 15) >> 2)) * 64;
    const int jmax = 4 * qb + 4;
    const int qrel = wid * 32 + r32;
    const int j0 = (MODE == 0) ? jmax : 0;
    ATT_DMA_K(j0, (j0 & 1) * 8192); ATT_DMA_V(j0, (j0 & 1) * 8192);
    bf16x8 qr[4];
#pragma unroll
    for (int d0 = 0; d0 < 4; ++d0) qr[d0] = *(const bf16x8*)(Qw + (size_t)r32 * DM + d0 * 16 + hi * 8);
    f32x16 o[2]; o[0] = f32x16{}; o[1] = f32x16{};
    float Cc = 1.f;
    float mrow = -1e30f, lsum = 0.f;
    f32x16 cin = f32x16{};
    if (MODE == 1) { const float ft = -((const LAS float*)(shm + A_NB))[64 + qb * 256 + qrel];
#pragma unroll
        for (int r = 0; r < 16; ++r) cin[r] = ft; }
    bool done = false;
    LAS unsigned* flags = (LAS unsigned*)(shm + A_FLAG);
    for (int jj = 0; jj <= jmax; ++jj) {
        const int j = (MODE == 0) ? jmax - jj : jj;
        const int s = (j & 1) * 8192;
        ATT_WAIT_BAR(0);
        if (MODE == 0 && jj > 0) { const LAS u32x4* fp = (const LAS u32x4*)(flags + ((jj + 1) & 1) * 8); const u32x4 fa = fp[0], fb = fp[1];
            if ((fa.x & fa.y & fa.z & fa.w & fb.x & fb.y & fb.z & fb.w) != 0u) break; }
        if (jj < jmax) { const int jn = (MODE == 0) ? j - 1 : j + 1; ATT_DMA_K(jn, (jn & 1) * 8192); ATT_DMA_V(jn, (jn & 1) * 8192); }
        const int jb = j - (4 * qb + 1);
        const bool active = !done && (64 * jb <= wid * 32 + 31 - (MODE == 0 ? 1 : 0));
        if (active) {
            f32x16 p0, p1;
            qkt(p0, p1, shm + A_K + s, qr, cin, r32, hi);
            if (MODE == 0) {
                float A0[16], A1[16], G[8];
#pragma unroll
                for (int g = 0; g < 4; ++g) {
                    float w0[4], w1[4], b0[4], b1[4];
#pragma unroll
                    for (int i = 0; i < 4; ++i) { const int r = 4 * g + i;
                        const float e0 = fexp2(fminf(p0[r], 80.f)), e1 = fexp2(fminf(p1[r], 80.f));
                        b0[i] = frcp(1.f + e0); b1[i] = frcp(1.f + e1); w0[i] = e0 * b0[i]; w1[i] = e1 * b1[i]; }
                    if (jb >= 0 || j == 0) {
#pragma unroll
                        for (int i = 0; i < 4; ++i) { const int k0 = crow(4 * g + i, hi), k1 = k0 + 32;
                            const bool v0 = (j == 0) ? (k0 >= 48) : (64 * jb + k0 < qrel), v1 = (j == 0) ? (k1 >= 48) : (64 * jb + k1 < qrel);
                            b0[i] = v0 ? b0[i] : 0.f; w0[i] = v0 ? w0[i] : 1.f; b1[i] = v1 ? b1[i] : 0.f; w1[i] = v1 ? w1[i] : 1.f; }
                    }
                    { const float t2 = w0[3], t1 = t2 * w0[2], t0 = t1 * w0[1]; G[g] = t0 * w0[0]; A0[4 * g + 3] = b0[3]; A0[4 * g + 2] = b0[2] * t2; A0[4 * g + 1] = b0[1] * t1; A0[4 * g] = b0[0] * t0; }
                    { const float t2 = w1[3], t1 = t2 * w1[2], t0 = t1 * w1[1]; G[4 + g] = t0 * w1[0]; A1[4 * g + 3] = b1[3]; A1[4 * g + 2] = b1[2] * t2; A1[4 * g + 1] = b1[1] * t1; A1[4 * g] = b1[0] * t0; }
                }
                float GG[16];
#pragma unroll
                for (int g = 0; g < 8; ++g) { float oh; const float ol = swap_lo(G[g], oh); GG[2 * g] = ol; GG[2 * g + 1] = oh; }
                float Tx[16]; Tx[15] = Cc;
#pragma unroll
                for (int x = 14; x >= 0; --x) Tx[x] = Tx[x + 1] * GG[x + 1];
                Cc = Tx[0] * GG[0];
#pragma unroll
                for (int g = 0; g < 4; ++g) { const float t0 = hi ? Tx[2 * g + 1] : Tx[2 * g], t1 = hi ? Tx[8 + 2 * g + 1] : Tx[8 + 2 * g];
#pragma unroll
                    for (int i = 0; i < 4; ++i) { p0[4 * g + i] = A0[4 * g + i] * t0; p1[4 * g + i] = A1[4 * g + i] * t1; } }
                done = __all(Cc == 0.f);
            } else {
                const LAS f32x4* nbp = (const LAS f32x4*)(shm + A_NB) + 16 * j + hi;
#pragma unroll
                for (int g = 0; g < 4; ++g) { const f32x4 n0 = nbp[2 * g], n1 = nbp[2 * g + 8];
#pragma unroll
                    for (int i = 0; i < 4; ++i) { p0[4 * g + i] += n0[i]; p1[4 * g + i] += n1[i]; } }
                if (jb >= 0) {
#pragma unroll
                    for (int r = 0; r < 16; ++r) { const int k0 = 64 * jb + crow(r, hi); if (k0 > qrel) p0[r] = -INFINITY; if (k0 + 32 > qrel) p1[r] = -INFINITY; }
                }
                float rm = fmaxf(p0[0], p1[0]);
#pragma unroll
                for (int r = 1; r < 16; ++r) rm = fmaxf(rm, fmaxf(p0[r], p1[r]));
                { float oh; const float ol = swap_lo(rm, oh); rm = fmaxf(ol, oh); }
                const float mnew = fmaxf(mrow, rm);
                if (__any(mnew > mrow)) {
                    const float f = fexp2(mrow - mnew); lsum *= f; if (hi == 0) wsf[r32] = f; mrow = mnew;
                    LDS_WAIT();
#pragma unroll
                    for (int r = 0; r < 16; ++r) { const float fr_ = wsf[crow(r, hi)]; o[0][r] *= fr_; o[1][r] *= fr_; }
                }
                float sacc = 0.f;
#pragma unroll
                for (int r = 0; r < 16; ++r) { p0[r] = fexp2(p0[r] - mrow); p1[r] = fexp2(p1[r] - mrow); sacc += p0[r] + p1[r]; }
                lsum += sacc;
            }
            u32x4 pw0, pw1, pw2, pw3;
            pw0 = (u32x4){cvtpk_s(p0[0], p0[1]), cvtpk_s(p0[2], p0[3]), cvtpk_s(p0[4], p0[5]), cvtpk_s(p0[6], p0[7])};
            pw1 = (u32x4){cvtpk_s(p0[8], p0[9]), cvtpk_s(p0[10], p0[11]), cvtpk_s(p0[12], p0[13]), cvtpk_s(p0[14], p0[15])};
            pw2 = (u32x4){cvtpk_s(p1[0], p1[1]), cvtpk_s(p1[2], p1[3]), cvtpk_s(p1[4], p1[5]), cvtpk_s(p1[6], p1[7])};
            pw3 = (u32x4){cvtpk_s(p1[8], p1[9]), cvtpk_s(p1[10], p1[11]), cvtpk_s(p1[12], p1[13]), cvtpk_s(p1[14], p1[15])};
            pv(o, vb0 + s, __builtin_bit_cast(bf16x8, pw0), __builtin_bit_cast(bf16x8, pw1), __builtin_bit_cast(bf16x8, pw2), __builtin_bit_cast(bf16x8, pw3));
        }
        if (MODE == 0 && lane == 0) flags[(jj & 1) * 8 + wid] = done ? 1u : 0u;
    }
    float rli[16];
    if (MODE == 1) {
        { float oh; const float ol = swap_lo(lsum, oh); lsum = ol + oh; }
        if (hi == 0) wsf[32 + r32] = lsum; LDS_WAIT();
#pragma unroll
        for (int r = 0; r < 16; ++r) rli[r] = frcp(wsf[32 + crow(r, hi)]);
    } else {
#pragma unroll
        for (int r = 0; r < 16; ++r) rli[r] = 1.f;
    }
    bf16* Ow = O + ((size_t)b * SEQ + qb * 256 + wid * 32) * DM + h * HD;
    { LAS bf16* stg = (LAS bf16*)(shm + A_OST) + wid * 2048;
#pragma unroll
        for (int r = 0; r < 16; ++r) { const int orow = crow(r, hi);
#pragma unroll
            for (int d0 = 0; d0 < 2; ++d0) stg[orow * 64 + d0 * 32 + r32] = (bf16)f2bf(o[d0][r] * rli[r]); }
        LDS_WAIT();
#pragma unroll
        for (int i = 0; i < 4; ++i) { const int row = i * 8 + (lane >> 3), ch = lane & 7; const u32x4 v = *(const LAS u32x4*)(stg + row * 64 + ch * 8); *(u32x4*)(Ow + (size_t)row * DM + ch * 8) = v; } }
    asm volatile("s_waitcnt vmcnt(0) lgkmcnt(0)\n\ts_barrier" ::: "memory");
#undef ATT_DMA_K
#undef ATT_DMA_V
}
__device__ __forceinline__ void sb_unit_wave(int b, int h, int qb, const bf16* Q, const bf16* __restrict__ K, const bf16* __restrict__ V, bf16* O, LAS unsigned char* shm) {
    int tid_ = threadIdx.x; asm volatile("" : "+v"(tid_));
    const int tid = tid_, lane = tid & 63, r32 = lane & 31, hi = lane >> 5; const int wid = __builtin_amdgcn_readfirstlane(tid >> 6);
    const bf16* Qw = Q + ((size_t)b * SEQ + qb * 256 + wid * 32) * DM + h * HD;
    const bf16* Kh = K + (size_t)b * KROWS * DM + h * HD; const bf16* Vh = V + (size_t)b * KROWS * DM + h * HD;
    LAS unsigned char* kslot = shm + wid * 16384; LAS unsigned char* vslot = kslot + 8192;
    const unsigned kdst = (unsigned)(uintptr_t)kslot, vdst = (unsigned)(uintptr_t)vslot;
    const bf16* ksrcE = Kh + (size_t)(lane >> 3) * DM + (((lane & 7) ^ (lane >> 4)) * 8);
    const bf16* ksrcO = Kh + (size_t)(lane >> 3) * DM + (((lane & 7) ^ (lane >> 4) ^ 4) * 8);
    int kaddr[4];
#pragma unroll
    for (int d0 = 0; d0 < 4; ++d0) kaddr[d0] = r32 * 128 + ((((hi ^ ((r32 >> 1) & 7)) ^ (2 * d0)) << 4));
    const bf16* vsrc = Vh + (size_t)(lane >> 2) * DM + (lane & 3) * 8;
#define SB_DMA_K(t) do { _Pragma("unroll") for (int c_ = 0; c_ < 8; ++c_) glds16(((c_ & 1) ? ksrcO : ksrcE) + (size_t)((t) * 64 + 8 * c_) * DM, (unsigned)__builtin_amdgcn_readfirstlane((int)(kdst + c_ * 1024))); } while (0)
#define SB_DMA_V(t) do { _Pragma("unroll") for (int p_ = 0; p_ < 8; ++p_) glds16(vsrc + (size_t)(t) * 64 * DM + (size_t)(16 * (p_ & 3)) * DM + (p_ >> 2) * 32, (unsigned)__builtin_amdgcn_readfirstlane((int)(vdst + p_ * 1024))); } while (0)
    const int vb0 = (int)vdst + ((lane >> 4) & 1) * 32 + (lane & 3) * 8 + (4 * hi + ((lane & 15) >> 2)) * 64;
    const int qrel = wid * 32 + r32;
    const int jhi = 4 * qb + 1 + (wid >> 1);
    SB_DMA_K(jhi); SB_DMA_V(jhi);
    bf16x8 qr[4];
#pragma unroll
    for (int d0 = 0; d0 < 4; ++d0) qr[d0] = *(const bf16x8*)(Qw + (size_t)r32 * DM + d0 * 16 + hi * 8);
    f32x16 o[2]; o[0] = f32x16{}; o[1] = f32x16{};
    float Cc = 1.f; const f32x16 zero16 = f32x16{};
    for (int j = jhi; j >= 0; --j) {
        asm volatile("s_waitcnt vmcnt(8)" ::: "memory");
        f32x16 p0, p1;
#pragma unroll
        for (int d0 = 0; d0 < 4; ++d0) {
            const bf16x8 b0 = *(const LAS bf16x8*)(kslot + kaddr[d0]);
            const bf16x8 b1 = *(const LAS bf16x8*)(kslot + kaddr[d0] + 4096);
            if (d0 == 0) { p0 = __builtin_amdgcn_mfma_f32_32x32x16_bf16(b0, qr[0], zero16, 0, 0, 0); p1 = __builtin_amdgcn_mfma_f32_32x32x16_bf16(b1, qr[0], zero16, 0, 0, 0); }
            else { p0 = __builtin_amdgcn_mfma_f32_32x32x16_bf16(b0, qr[d0], p0, 0, 0, 0); p1 = __builtin_amdgcn_mfma_f32_32x32x16_bf16(b1, qr[d0], p1, 0, 0, 0); } }
        asm volatile("s_waitcnt lgkmcnt(0)" ::: "memory");
        if (j > 0) SB_DMA_K(j - 1);
        const int jb = j - (4 * qb + 1);
        {
            float A0[16], A1[16], G[8];
#pragma unroll
            for (int g = 0; g < 4; ++g) {
                float w0[4], w1[4], b0[4], b1[4];
#pragma unroll
                for (int i = 0; i < 4; ++i) { const int r = 4 * g + i;
                    const float e0 = fexp2(fminf(p0[r], 80.f)), e1 = fexp2(fminf(p1[r], 80.f));
                    b0[i] = frcp(1.f + e0); b1[i] = frcp(1.f + e1); w0[i] = e0 * b0[i]; w1[i] = e1 * b1[i]; }
                if (jb >= 0 || j == 0) {
#pragma unroll
                    for (int i = 0; i < 4; ++i) { const int k0 = crow(4 * g + i, hi), k1 = k0 + 32;
                        const bool v0 = (j == 0) ? (k0 >= 48) : (64 * jb + k0 < qrel), v1 = (j == 0) ? (k1 >= 48) : (64 * jb + k1 < qrel);
                        b0[i] = v0 ? b0[i] : 0.f; w0[i] = v0 ? w0[i] : 1.f; b1[i] = v1 ? b1[i] : 0.f; w1[i] = v1 ? w1[i] : 1.f; }
                }
                { const float t2 = w0[3], t1 = t2 * w0[2], t0 = t1 * w0[1]; G[g] = t0 * w0[0]; A0[4 * g + 3] = b0[3]; A0[4 * g + 2] = b0[2] * t2; A0[4 * g + 1] = b0[1] * t1; A0[4 * g] = b0[0] * t0; }
                { const float t2 = w1[3], t1 = t2 * w1[2], t0 = t1 * w1[1]; G[4 + g] = t0 * w1[0]; A1[4 * g + 3] = b1[3]; A1[4 * g + 2] = b1[2] * t2; A1[4 * g + 1] = b1[1] * t1; A1[4 * g] = b1[0] * t0; }
            }
            float GG[16];
#pragma unroll
            for (int g = 0; g < 8; ++g) { float oh; const float ol = swap_lo(G[g], oh); GG[2 * g] = ol; GG[2 * g + 1] = oh; }
            float Tx[16]; Tx[15] = Cc;
#pragma unroll
            for (int x = 14; x >= 0; --x) Tx[x] = Tx[x + 1] * GG[x + 1];
            Cc = Tx[0] * GG[0];
#pragma unroll
            for (int g = 0; g < 4; ++g) { const float t0 = hi ? Tx[2 * g + 1] : Tx[2 * g], t1 = hi ? Tx[8 + 2 * g + 1] : Tx[8 + 2 * g];
#pragma unroll
                for (int i = 0; i < 4; ++i) { p0[4 * g + i] = A0[4 * g + i] * t0; p1[4 * g + i] = A1[4 * g + i] * t1; } }
        }
        u32x4 pw0, pw1, pw2, pw3;
        pw0 = (u32x4){cvtpk_s(p0[0], p0[1]), cvtpk_s(p0[2], p0[3]), cvtpk_s(p0[4], p0[5]), cvtpk_s(p0[6], p0[7])};
        pw1 = (u32x4){cvtpk_s(p0[8], p0[9]), cvtpk_s(p0[10], p0[11]), cvtpk_s(p0[12], p0[13]), cvtpk_s(p0[14], p0[15])};
        pw2 = (u32x4){cvtpk_s(p1[0], p1[1]), cvtpk_s(p1[2], p1[3]), cvtpk_s(p1[4], p1[5]), cvtpk_s(p1[6], p1[7])};
        pw3 = (u32x4){cvtpk_s(p1[8], p1[9]), cvtpk_s(p1[10], p1[11]), cvtpk_s(p1[12], p1[13]), cvtpk_s(p1[14], p1[15])};
        if (j > 0) asm volatile("s_waitcnt vmcnt(8)" ::: "memory"); else asm volatile("s_waitcnt vmcnt(0)" ::: "memory");
        pv(o, vb0, __builtin_bit_cast(bf16x8, pw0), __builtin_bit_cast(bf16x8, pw1), __builtin_bit_cast(bf16x8, pw2), __builtin_bit_cast(bf16x8, pw3));
        const bool done = __all(Cc == 0.f);
        if (done) break;
        if (j > 0) SB_DMA_V(j - 1);
    }
    asm volatile("s_waitcnt vmcnt(0) lgkmcnt(0)" ::: "memory");
    bf16* Ow = O + ((size_t)b * SEQ + qb * 256 + wid * 32) * DM + h * HD;
    { LAS bf16* stg = (LAS bf16*)kslot;
#pragma unroll
        for (int r = 0; r < 16; ++r) { const int orow = crow(r, hi);
#pragma unroll
            for (int d0 = 0; d0 < 2; ++d0) stg[orow * 64 + d0 * 32 + r32] = (bf16)f2bf(o[d0][r]); }
        LDS_WAIT();
#pragma unroll
        for (int i = 0; i < 4; ++i) { const int row = i * 8 + (lane >> 3), ch = lane & 7; const u32x4 v = *(const LAS u32x4*)(stg + row * 64 + ch * 8); *(u32x4*)(Ow + (size_t)row * DM + ch * 8) = v; } }
    asm volatile("s_waitcnt lgkmcnt(0)" ::: "memory");
#undef SB_DMA_K
#undef SB_DMA_V
}
__device__ __forceinline__ void sb_unit_win(int b, int h, int qb, const bf16* Q, const bf16* __restrict__ K, const bf16* __restrict__ V, bf16* O, LAS unsigned char* shm) {
    int tid_ = threadIdx.x; asm volatile("" : "+v"(tid_));
    const int tid = tid_, lane = tid & 63, r32 = lane & 31, hi = lane >> 5; const int wid = __builtin_amdgcn_readfirstlane(tid >> 6);
    const bf16* Qw = Q + ((size_t)b * SEQ + qb * 256 + wid * 32) * DM + h * HD;
    const bf16* Kh = K + (size_t)b * KROWS * DM + h * HD; const bf16* Vh = V + (size_t)b * KROWS * DM + h * HD;
    const unsigned lds0 = (unsigned)(uintptr_t)shm;
    const bf16* ksrc = Kh + (size_t)lane * DM + wid * 8;
    const bf16* vsrc = Vh + (size_t)(16 * (wid & 3) + (lane >> 2)) * DM + (wid >> 2) * 32 + (lane & 3) * 8;
    const int vb0 = (int)(lds0 + 8192) + ((lane >> 4) & 1) * 32 + (lane & 3) * 8 + (4 * hi + ((lane & 15) >> 2)) * 64;
    const int qrel = wid * 32 + r32;
    const int jhi = 4 * qb + 1 + (wid >> 1);
    LAS unsigned* flags = (LAS unsigned*)(shm + 7 * 16384);
    bf16x8 qr[4];
#pragma unroll
    for (int d0 = 0; d0 < 4; ++d0) qr[d0] = *(const bf16x8*)(Qw + (size_t)r32 * DM + d0 * 16 + hi * 8);
    f32x16 o[2]; o[0] = f32x16{}; o[1] = f32x16{};
    float Cc = 1.f; const f32x16 zero16 = f32x16{}; bool done = false;
    int jtop = 4 * qb + 4;
    for (;;) {
        const int jlo = jtop > 6 ? jtop - 6 : 0;
        for (int j = jtop; j >= jlo; --j) { const unsigned so = (unsigned)(jtop - j) * 16384u;
            glds16(ksrc + (size_t)j * 64 * DM, (unsigned)__builtin_amdgcn_readfirstlane((int)(lds0 + so + wid * 1024)));
            glds16(vsrc + (size_t)j * 64 * DM, (unsigned)__builtin_amdgcn_readfirstlane((int)(lds0 + so + 8192 + wid * 1024))); }
        asm volatile("s_waitcnt vmcnt(0) lgkmcnt(0)\n\ts_barrier" ::: "memory");
        f32x16 n0 = zero16, n1 = zero16;
        if (!done) qkt(n0, n1, shm + (jtop - (jhi < jtop ? jhi : jtop)) * 16384, qr, zero16, r32, hi);
        if (!done) for (int j = (jhi < jtop ? jhi : jtop); j >= jlo; --j) {
            const int so = (jtop - j) * 16384;
            f32x16 p0 = n0, p1 = n1;
            if (j > jlo) qkt(n0, n1, shm + so + 16384, qr, zero16, r32, hi);
            const int jb = j - (4 * qb + 1);
            {
                float A0[16], A1[16], G[8];
#pragma unroll
                for (int g = 0; g < 4; ++g) {
                    float w0[4], w1[4], b0[4], b1[4];
#pragma unroll
                    for (int i = 0; i < 4; ++i) { const int r = 4 * g + i;
                        const float e0 = fexp2(__builtin_amdgcn_fmed3f(p0[r], -3.0e38f, 80.f)), e1 = fexp2(__builtin_amdgcn_fmed3f(p1[r], -3.0e38f, 80.f));
                        b0[i] = frcp(1.f + e0); b1[i] = frcp(1.f + e1); w0[i] = e0 * b0[i]; w1[i] = e1 * b1[i]; }
                    if (j == jhi || j == 0) {
#pragma unroll
                        for (int i = 0; i < 4; ++i) { const int k0 = crow(4 * g + i, hi), k1 = k0 + 32;
                            const bool v0 = (j == 0) ? (k0 >= 48) : (64 * jb + k0 < qrel), v1 = (j == 0) ? (k1 >= 48) : (64 * jb + k1 < qrel);
                            b0[i] = v0 ? b0[i] : 0.f; w0[i] = v0 ? w0[i] : 1.f; b1[i] = v1 ? b1[i] : 0.f; w1[i] = v1 ? w1[i] : 1.f; }
                    }
                    { const float t2 = w0[3], t1 = t2 * w0[2], t0 = t1 * w0[1]; G[g] = t0 * w0[0]; A0[4 * g + 3] = b0[3]; A0[4 * g + 2] = b0[2] * t2; A0[4 * g + 1] = b0[1] * t1; A0[4 * g] = b0[0] * t0; }
                    { const float t2 = w1[3], t1 = t2 * w1[2], t0 = t1 * w1[1]; G[4 + g] = t0 * w1[0]; A1[4 * g + 3] = b1[3]; A1[4 * g + 2] = b1[2] * t2; A1[4 * g + 1] = b1[1] * t1; A1[4 * g] = b1[0] * t0; }
                }
                float GG[16];
#pragma unroll
                for (int g = 0; g < 8; ++g) { float oh; const float ol = swap_lo(G[g], oh); GG[2 * g] = ol; GG[2 * g + 1] = oh; }
                float Tx[16]; Tx[15] = Cc;
#pragma unroll
                for (int x = 14; x >= 0; --x) Tx[x] = Tx[x + 1] * GG[x + 1];
                Cc = Tx[0] * GG[0];
#pragma unroll
                for (int g = 0; g < 4; ++g) { const float t0 = hi ? Tx[2 * g + 1] : Tx[2 * g], t1 = hi ? Tx[8 + 2 * g + 1] : Tx[8 + 2 * g];
#pragma unroll
                    for (int i = 0; i < 4; ++i) { p0[4 * g + i] = A0[4 * g + i] * t0; p1[4 * g + i] = A1[4 * g + i] * t1; } }
            }
            u32x4 pw0, pw1, pw2, pw3;
            pw0 = (u32x4){cvtpk_s(p0[0], p0[1]), cvtpk_s(p0[2], p0[3]), cvtpk_s(p0[4], p0[5]), cvtpk_s(p0[6], p0[7])};
            pw1 = (u32x4){cvtpk_s(p0[8], p0[9]), cvtpk_s(p0[10], p0[11]), cvtpk_s(p0[12], p0[13]), cvtpk_s(p0[14], p0[15])};
            pw2 = (u32x4){cvtpk_s(p1[0], p1[1]), cvtpk_s(p1[2], p1[3]), cvtpk_s(p1[4], p1[5]), cvtpk_s(p1[6], p1[7])};
            pw3 = (u32x4){cvtpk_s(p1[8], p1[9]), cvtpk_s(p1[10], p1[11]), cvtpk_s(p1[12], p1[13]), cvtpk_s(p1[14], p1[15])};
            pv(o, vb0 + so, __builtin_bit_cast(bf16x8, pw0), __builtin_bit_cast(bf16x8, pw1), __builtin_bit_cast(bf16x8, pw2), __builtin_bit_cast(bf16x8, pw3));
            done = __all(Cc == 0.f);
            if (done) break;
        }
        if (lane == 0) flags[wid] = done ? 1u : 0u;
        asm volatile("s_waitcnt lgkmcnt(0)\n\ts_barrier" ::: "memory");
        const u32x4 fa = *(const LAS u32x4*)flags, fb = *(const LAS u32x4*)(flags + 4);
        const bool alldone = (fa.x & fa.y & fa.z & fa.w & fb.x & fb.y & fb.z & fb.w) != 0u;
        if (alldone || jlo == 0) break;
        jtop = jlo - 1;
        asm volatile("s_waitcnt lgkmcnt(0)\n\ts_barrier" ::: "memory");
    }
    bf16* Ow = O + ((size_t)b * SEQ + qb * 256 + wid * 32) * DM + h * HD;
    { LAS bf16* stg = (LAS bf16*)(shm + wid * 4096);
#pragma unroll
        for (int r = 0; r < 16; ++r) { const int orow = crow(r, hi);
#pragma unroll
            for (int d0 = 0; d0 < 2; ++d0) stg[orow * 64 + d0 * 32 + r32] = (bf16)f2bf(o[d0][r]); }
        LDS_WAIT();
#pragma unroll
        for (int i = 0; i < 4; ++i) { const int row = i * 8 + (lane >> 3), ch = lane & 7; const u32x4 v = *(const LAS u32x4*)(stg + row * 64 + ch * 8); *(u32x4*)(Ow + (size_t)row * DM + ch * 8) = v; } }
    asm volatile("s_waitcnt lgkmcnt(0)\n\ts_barrier" ::: "memory");
}
#undef ATT_WAIT_BAR
}
namespace fox {
using f32x4_=__attribute__((ext_vector_type(4)))float;
constexpr int D=64,NW=8,QBLK=32,QB=QBLK*NW,KVBLK=64;
__device__ __forceinline__ int crow(int r,int hi){return (r&3)+8*(r>>2)+4*hi;}
#define SBAR() __builtin_amdgcn_sched_barrier(0)
__device__ __forceinline__ void cmask(f32x16&p0,f32x16&p1,int jb,int qrel,int hi){
  const float NEG=-INFINITY; int kb=64*jb+4*hi;
  #pragma unroll
  for(int r=0;r<16;++r){int kv=kb+(r&3)+8*(r>>2); if(kv>qrel)p0[r]=NEG; if(kv+32>qrel)p1[r]=NEG;}
}

constexpr int NSLOT=3, SLOTB=8192;
constexpr int LDS_K=0, LDS_V=NSLOT*SLOTB, LDS_WS=2*NSLOT*SLOTB, LDS_OST=LDS_WS+NW*64*4, LDS_BYTES=LDS_OST+NW*4096;
__device__ __forceinline__ void glds16(const void*gsrc,unsigned lds_dst){unsigned keep;
  asm volatile("s_mov_b32 %0, m0\n\ts_mov_b32 m0, %2\n\ts_nop 0\n\tglobal_load_lds_dwordx4 %1, off\n\ts_mov_b32 m0, %0":"=&s"(keep):"v"(gsrc),"s"(lds_dst):"memory");}
__device__ __forceinline__ float max3f(float a,float b,float c){float r;asm("v_max3_f32 %0, %1, %2, %3":"=v"(r):"v"(a),"v"(b),"v"(c));return r;}
__device__ __forceinline__ float max2f(float a,float b){float r;asm("v_max_f32_e32 %0, %1, %2":"=v"(r):"v"(a),"v"(b));return r;}
__device__ __forceinline__ float fadd_s(float a,float b){float r;asm("v_add_f32_e32 %0, %1, %2":"=v"(r):"v"(a),"v"(b));return r;}
__device__ __forceinline__ float fsub_s(float a,float b){float r;asm("v_sub_f32_e32 %0, %1, %2":"=v"(r):"v"(a),"v"(b));return r;}
typedef float f32x2_t __attribute__((ext_vector_type(2)));
__device__ __forceinline__ unsigned cvtpk_s(float lo,float hi){f32x2_t v={lo,hi};bf16x2_t b=__builtin_convertvector(v,bf16x2_t);return __builtin_bit_cast(unsigned,b);}
#define WAIT_BAR(N) asm volatile("s_waitcnt vmcnt(" #N ") lgkmcnt(0)\n\ts_barrier":::"memory")

__device__ __forceinline__ void qkt(f32x16&p0,f32x16&p1,const char*Kslot,const bf16x8*qr,const f32x16&negm,int r32,int hi){
  const char*kb=Kslot+hi*1024+r32*16;
  #pragma unroll
  for(int d0=0;d0<4;++d0){
    const bf16x8 b0=*reinterpret_cast<const bf16x8*>(kb+d0*2048);
    const bf16x8 b1=*reinterpret_cast<const bf16x8*>(kb+d0*2048+512);
    if(d0==0){p0=__builtin_amdgcn_mfma_f32_32x32x16_bf16(b0,qr[0],negm,0,0,0);p1=__builtin_amdgcn_mfma_f32_32x32x16_bf16(b1,qr[0],negm,0,0,0);}
    else{p0=__builtin_amdgcn_mfma_f32_32x32x16_bf16(b0,qr[d0],p0,0,0,0);p1=__builtin_amdgcn_mfma_f32_32x32x16_bf16(b1,qr[d0],p1,0,0,0);}}
}
typedef __attribute__((address_space(3))) const char* lds_cptr;
typedef short v4i16_t __attribute__((ext_vector_type(4)));
__device__ __forceinline__ void kload8(bf16x8*kf,lds_cptr kp){
  kf[0]=*(const __attribute__((address_space(3))) bf16x8*)(kp);      kf[1]=*(const __attribute__((address_space(3))) bf16x8*)(kp+512);
  kf[2]=*(const __attribute__((address_space(3))) bf16x8*)(kp+2048); kf[3]=*(const __attribute__((address_space(3))) bf16x8*)(kp+2560);
  kf[4]=*(const __attribute__((address_space(3))) bf16x8*)(kp+4096); kf[5]=*(const __attribute__((address_space(3))) bf16x8*)(kp+4608);
  kf[6]=*(const __attribute__((address_space(3))) bf16x8*)(kp+6144); kf[7]=*(const __attribute__((address_space(3))) bf16x8*)(kp+6656);
}
__device__ __forceinline__ void kload2(bf16x8*kf,lds_cptr kp,int j){ kf[2*j]=*(const __attribute__((address_space(3))) bf16x8*)(kp+j*2048); kf[2*j+1]=*(const __attribute__((address_space(3))) bf16x8*)(kp+j*2048+512); }
__device__ __forceinline__ s16x4 vtr(lds_cptr p){ return __builtin_bit_cast(s16x4,__builtin_amdgcn_ds_read_tr16_b64_v4i16((__attribute__((address_space(3))) v4i16_t*)p)); }
__device__ __forceinline__ float rowmax(const f32x16&p0,const f32x16&p1){
  float a=max3f(p0[0],p0[1],p1[0]),b=max3f(p0[2],p0[3],p1[1]);a=max3f(a,p1[2],p1[3]);
  #pragma unroll
  for(int r=4;r<16;r+=4){a=max3f(a,p0[r],p0[r+1]);b=max3f(b,p0[r+2],p0[r+3]);a=max3f(a,p1[r],p1[r+1]);b=max3f(b,p1[r+2],p1[r+3]);}
  const float m=max2f(a,b);
  auto rr=__builtin_amdgcn_permlane32_swap(__float_as_uint(m),__float_as_uint(m),false,false);
  return max2f(__uint_as_float(rr[0]),__uint_as_float(rr[1]));
}
__device__ __forceinline__ void pv(f32x16*o,int vb,bf16x8 pa0,bf16x8 pa1,bf16x8 pa2,bf16x8 pa3){
  #pragma unroll
  for(int d0=0;d0<2;++d0){s16x4 lo[4],hi[4];
    #pragma unroll
    for(int ks=0;ks<4;++ks){
      asm volatile("ds_read_b64_tr_b16 %0,%1 offset:%c2":"=&v"(lo[ks]):"v"(vb),"i"(d0*4096+ks*1024):"memory");
      asm volatile("ds_read_b64_tr_b16 %0,%1 offset:%c2":"=&v"(hi[ks]):"v"(vb),"i"(d0*4096+ks*1024+512):"memory");}
    asm volatile("s_waitcnt lgkmcnt(0)":::"memory");SBAR();
    #define PK(k) (bf16x8){lo[k][0],lo[k][1],lo[k][2],lo[k][3],hi[k][0],hi[k][1],hi[k][2],hi[k][3]}
    o[d0]=__builtin_amdgcn_mfma_f32_32x32x16_bf16(pa0,PK(0),o[d0],0,0,0);
    o[d0]=__builtin_amdgcn_mfma_f32_32x32x16_bf16(pa1,PK(1),o[d0],0,0,0);
    o[d0]=__builtin_amdgcn_mfma_f32_32x32x16_bf16(pa2,PK(2),o[d0],0,0,0);
    o[d0]=__builtin_amdgcn_mfma_f32_32x32x16_bf16(pa3,PK(3),o[d0],0,0,0);
    #undef PK
  }
}

#define ATTN_STORE16(p,v) (*(u32x4*)(p)=(v))

constexpr int LDS_NB=LDS_BYTES, LDS_SCAN=LDS_NB+KROWS*4, LDS_KAUG=LDS_SCAN+64, LDS_TOTAL=LDS_KAUG+KROWS*16;
static_assert(LDS_TOTAL<=RING_BYTES,"fox lds");
template<int THRL> __device__ __forceinline__ void attn_unit(int b,int h,int qb,const bf16*Q,const bf16*__restrict__ K,const bf16*__restrict__ V,bf16*O,char*shm){
  int tid_=threadIdx.x; asm volatile("":"+v"(tid_));
  const int tid=tid_,lane=tid&63,r32=lane&31,hi=lane>>5; const int wid=__builtin_amdgcn_readfirstlane(tid>>6);
  const long rowbase=(long)b*SEQ, krowbase=(long)b*KROWS; const int q0=qb*QB;
  const bf16*Qw=Q+(rowbase+q0+wid*QBLK)*DM+h*D;
  const bf16*Kh=K+krowbase*DM+h*D,*Vh=V+krowbase*DM+h*D;
  const unsigned lds0=(unsigned)(uintptr_t)shm;
  float*wsf=(float*)(shm+LDS_WS)+wid*64;
  const bf16*ksrc=Kh+(long)lane*DM+wid*8;
  const bf16*vsrc=Vh+(long)(16*(wid&3)+(lane>>2))*DM+(wid>>2)*32+(lane&3)*8;
  const unsigned kdst=lds0+LDS_K+wid*1024, vdst=lds0+LDS_V+wid*1024;
  #define DMA_K(t,slot) glds16(ksrc+(long)(t)*KVBLK*DM,(unsigned)__builtin_amdgcn_readfirstlane(kdst+(slot)))
  #define DMA_V(t,slot) glds16(vsrc+(long)(t)*KVBLK*DM,(unsigned)__builtin_amdgcn_readfirstlane(vdst+(slot)))
  const int vb0=(int)(lds0+LDS_V)+((lane>>4)&1)*32+(lane&3)*8+(4*hi+((lane&15)>>2))*64;
  const char*Kbase=shm+LDS_K; bf16x8 kf[8];
  const lds_cptr shm3=(lds_cptr)shm; const lds_cptr kp0=shm3+LDS_K+hi*1024+r32*16; const lds_cptr vp0=shm3+LDS_V+((lane>>4)&1)*32+(lane&3)*8+(4*hi+((lane&15)>>2))*64;
  const int NT=(q0+QB)/KVBLK+1;
  DMA_K(0,0);DMA_V(0,0);DMA_K(1,SLOTB);
  bf16x8 qr[4];
  #pragma unroll
  for(int d0=0;d0<4;++d0)qr[d0]=*reinterpret_cast<const bf16x8*>(&Qw[(long)r32*DM+d0*16+hi*8]);
  const int qrel=wid*QBLK+r32;
  const __attribute__((address_space(3))) float*nbl=(const __attribute__((address_space(3))) float*)((lds_cptr)shm+LDS_NB);
  const lds_cptr kaugl=(lds_cptr)shm+LDS_KAUG+r32*16;
  const bf16x8 qaug=hi?(bf16x8){0,0,0,0,0,0,0,0}:(bf16x8){0x3F80,0x3F80,0x3F80,0,0,0,0,0};
  const float ft=-nbl[64+q0+qrel];
  float mhat=-ft,l_reg=0.f;f32x16 o[2];o[0]=f32x16{};o[1]=f32x16{};f32x16 negm;
  _Pragma("unroll") for(int r=0;r<16;++r)negm[r]=ft; asm volatile("":"+v"(negm));
  #define NBADD(P0,P1,t) do{ const __attribute__((address_space(3))) f32x4_*nbp_=(const __attribute__((address_space(3))) f32x4_*)nbl+16*(t)+hi; \
    _Pragma("unroll") for(int g_=0;g_<4;++g_){ const f32x4_ n0_=nbp_[2*g_],n1_=nbp_[2*g_+8]; _Pragma("unroll") for(int i_=0;i_<4;++i_){P0[4*g_+i_]+=n0_[i_];P1[4*g_+i_]+=n1_[i_];} } }while(0)
  #define CMASK(P0,P1,t) do{int jb_=(t)-(NT-4); if(jb_>=0)cmask(P0,P1,jb_,qrel,hi);}while(0)
  bool resc=false;
  #define START(P0,P1) do{ const float rm=rowmax(P0,P1); resc=false; \
    { const float dl=max2f(rm,0.f); mhat=fadd_s(mhat,dl);   \
      _Pragma("unroll") for(int r=0;r<16;++r){P0[r]=fsub_s(P0[r],dl);P1[r]=fsub_s(P1[r],dl);} \
      _Pragma("unroll") for(int r=0;r<16;++r)negm[r]=-mhat; asm volatile("":"+v"(negm)); } \
    _Pragma("unroll") for(int r=0;r<16;++r)P0[r]=__builtin_amdgcn_exp2f(P0[r]); }while(0)
  #define RESC() do{ if(resc){ asm volatile("s_waitcnt lgkmcnt(0)":::"memory"); \
      _Pragma("unroll") for(int d_=0;d_<2;++d_) _Pragma("unroll") for(int r=0;r<16;++r)o[d_][r]*=wsf[crow(r,hi)]; } }while(0)
  f32x16 pA0,pA1,pB0,pB1;
  int sl_prev=0,sl_cur=0,sl_next=SLOTB;
  #define ROT() do{sl_prev=sl_cur;sl_cur=sl_next;sl_next=(sl_next==(NSLOT-1)*SLOTB)?0:sl_next+SLOTB;}while(0)
  DMA_K(2,2*SLOTB);
  WAIT_BAR(3);
  qkt(pA0,pA1,Kbase,qr,negm,r32,hi);asm volatile("s_nop 15\n\ts_nop 7":"+v"(pA0),"+v"(pA1));NBADD(pA0,pA1,0);CMASK(pA0,pA1,0);
  START(pA0,pA1);
  _Pragma("unroll") for(int r=0;r<16;++r)pA1[r]=__builtin_amdgcn_exp2f(pA1[r]);
  WAIT_BAR(0);
  DMA_K(3,0);DMA_V(1,SLOTB);
  ROT();
  kload8(kf,kp0+sl_cur);
  WAIT_BAR(2);
  s16x4 vlo[8],vhi[8]; u32x4 pw0,pw1,pw2,pw3;
  #define PKW(P,B) cvtpk_s(P[B],P[B+1])
  #define PAF(k) __builtin_bit_cast(bf16x8,pw##k)
  #define VFR(i) (bf16x8){vlo[i][0],vlo[i][1],vlo[i][2],vlo[i][3],vhi[i][0],vhi[i][1],vhi[i][2],vhi[i][3]}
  #define PIN(x) asm volatile("":"+v"(x))
  #define MX3(a,b,c) __builtin_fmaxf(__builtin_fmaxf((a),(b)),(c))
  #define GAPA(MF,A0,A1,A2,A3,W0,W1,PW) do{ MF; sacc+=A0; sacc+=A1; sacc+=A2; sacc+=A3; PIN(sacc); W0; W1; PIN(PW); SBAR(); }while(0)
  #define EX(v) __builtin_amdgcn_exp2f(v)
  #define GAPB(MF,X,B) do{ MF; X[B]=EX(X[B]); X[B+1]=EX(X[B+1]); X[B+2]=EX(X[B+2]); X[B+3]=EX(X[B+3]); PIN(X); SBAR(); }while(0)
  #define VRD(i) do{ vlo[i]=vtr(vp_+(((i)>>2)*4096+((i)&3)*1024)); vhi[i]=vtr(vp_+(((i)>>2)*4096+((i)&3)*1024+512)); }while(0)
  #define KRD(G,j) do{ if(G){ kload2(kf,kp0+sl_next,j); SBAR(); } }while(0)
  #define STEP(C0,C1,P0,P1,t,GK,GV,GL) do{ SBAR(); \
    const lds_cptr vp_=vp0+sl_prev; \
    const bf16x8 ka0_=*(const __attribute__((address_space(3))) bf16x8*)(kaugl+(t)*1024), ka1_=*(const __attribute__((address_space(3))) bf16x8*)(kaugl+(t)*1024+512); \
    VRD(0); SBAR(); float sacc=(P0[0]+P0[1]); \
    C0=__builtin_amdgcn_mfma_f32_32x32x16_bf16(ka0_,qaug,negm,0,0,0); C1=__builtin_amdgcn_mfma_f32_32x32x16_bf16(ka1_,qaug,negm,0,0,0); SBAR(); \
    GAPA(C0=__builtin_amdgcn_mfma_f32_32x32x16_bf16(kf[0],qr[0],C0,0,0,0), P0[2],P0[3],P0[4],P0[5],     pw0[0]=PKW(P0,0), pw0[1]=PKW(P0,2), pw0); \
    VRD(4); SBAR(); GAPA(C1=__builtin_amdgcn_mfma_f32_32x32x16_bf16(kf[1],qr[0],C1,0,0,0), P0[6],P0[7],P0[8],P0[9],     pw0[2]=PKW(P0,4), pw0[3]=PKW(P0,6), pw0); \
    VRD(1); SBAR(); GAPA(C0=__builtin_amdgcn_mfma_f32_32x32x16_bf16(kf[2],qr[1],C0,0,0,0),   P0[10],P0[11],P0[12],P0[13], pw1[0]=PKW(P0,8), pw1[1]=PKW(P0,10), pw1); \
    VRD(5); SBAR(); GAPA(C1=__builtin_amdgcn_mfma_f32_32x32x16_bf16(kf[3],qr[1],C1,0,0,0),   P0[14],P0[15],P1[0],P1[1],   pw1[2]=PKW(P0,12),pw1[3]=PKW(P0,14), pw1); \
    VRD(2); SBAR(); GAPA(C0=__builtin_amdgcn_mfma_f32_32x32x16_bf16(kf[4],qr[2],C0,0,0,0),   P1[2],P1[3],P1[4],P1[5],     pw2[0]=PKW(P1,0), pw2[1]=PKW(P1,2), pw2); \
    VRD(6); SBAR(); GAPA(C1=__builtin_amdgcn_mfma_f32_32x32x16_bf16(kf[5],qr[2],C1,0,0,0),   P1[6],P1[7],P1[8],P1[9],     pw2[2]=PKW(P1,4), pw2[3]=PKW(P1,6), pw2); \
    VRD(3); SBAR(); GAPA(C0=__builtin_amdgcn_mfma_f32_32x32x16_bf16(kf[6],qr[3],C0,0,0,0),   P1[10],P1[11],P1[12],P1[13], pw3[0]=PKW(P1,8), pw3[1]=PKW(P1,10), pw3); \
    VRD(7); SBAR(); GAPA(C1=__builtin_amdgcn_mfma_f32_32x32x16_bf16(kf[7],qr[3],C1,0,0,0),   P1[14],P1[15],0.f,0.f,       pw3[2]=PKW(P1,12),pw3[3]=PKW(P1,14), pw3); \
    l_reg+=sacc; \
    if(GK){DMA_K((t)+3,sl_cur);} if(GV){DMA_V((t)+1,sl_next);} \
    CMASK(C0,C1,t); \
    { float a=MX3(C0[0],C0[1],C1[0]),b=MX3(C0[2],C0[3],C1[1]); a=MX3(a,C1[2],C1[3]); \
      _Pragma("unroll") for(int r=4;r<16;r+=4){a=MX3(a,C0[r],C0[r+1]);b=MX3(b,C0[r+2],C0[r+3]);a=MX3(a,C1[r],C1[r+1]);b=MX3(b,C1[r+2],C1[r+3]);} \
      float rm=__builtin_fmaxf(a,b); { auto rr=__builtin_amdgcn_permlane32_swap(__float_as_uint(rm),__float_as_uint(rm),false,false); rm=__builtin_fmaxf(__uint_as_float(rr[0]),__uint_as_float(rr[1])); } \
      resc=false; \
      if(__builtin_expect(__any(rm>(float)THRL),0)){ const float dl=__builtin_fmaxf(rm,0.f); mhat+=dl; \
        _Pragma("unroll") for(int r=0;r<16;++r){C0[r]-=dl;C1[r]-=dl;} \
        _Pragma("unroll") for(int r=0;r<16;++r)negm[r]=-mhat; asm volatile("":"+v"(negm)); \
        const float f=__builtin_amdgcn_exp2f(-dl); l_reg*=f; if(hi==0)wsf[r32]=f; resc=true; } } \
    SBAR(); \
    GAPB(o[0]=__builtin_amdgcn_mfma_f32_32x32x16_bf16(PAF(0),VFR(0),o[0],0,0,0), C0,0); \
    GAPB(o[1]=__builtin_amdgcn_mfma_f32_32x32x16_bf16(PAF(0),VFR(4),o[1],0,0,0), C0,4); \
    KRD(GL,0); GAPB(o[0]=__builtin_amdgcn_mfma_f32_32x32x16_bf16(PAF(1),VFR(1),o[0],0,0,0), C0,8); \
    KRD(GL,1); GAPB(o[1]=__builtin_amdgcn_mfma_f32_32x32x16_bf16(PAF(1),VFR(5),o[1],0,0,0), C0,12); \
    KRD(GL,2); GAPB(o[0]=__builtin_amdgcn_mfma_f32_32x32x16_bf16(PAF(2),VFR(2),o[0],0,0,0), C1,0); \
    KRD(GL,3); GAPB(o[1]=__builtin_amdgcn_mfma_f32_32x32x16_bf16(PAF(2),VFR(6),o[1],0,0,0), C1,4); \
    GAPB(o[0]=__builtin_amdgcn_mfma_f32_32x32x16_bf16(PAF(3),VFR(3),o[0],0,0,0), C1,8); \
    GAPB(o[1]=__builtin_amdgcn_mfma_f32_32x32x16_bf16(PAF(3),VFR(7),o[1],0,0,0), C1,12); \
    }while(0)
  int t=1;
  STEP(pB0,pB1,pA0,pA1,1,true,true,true); WAIT_BAR(2); RESC(); ROT();
  pA0=pB0; pA1=pB1; t=2;
  #undef CMASK
  #define CMASK(P0,P1,t) do{}while(0)
  for(;t+5<NT;t+=2){
    STEP(pB0,pB1,pA0,pA1,t,true,true,true);     WAIT_BAR(2); RESC(); ROT();
    STEP(pA0,pA1,pB0,pB1,t+1,true,true,true);   WAIT_BAR(2); RESC(); ROT();
  }
  #undef CMASK
  #define CMASK(P0,P1,t) do{int jb_=(t)-(NT-4); if(jb_>=0)cmask(P0,P1,jb_,qrel,hi);}while(0)
  #define ENDW(tt) do{ if((tt)+3<NT){WAIT_BAR(2);} else if((tt)+2<NT){WAIT_BAR(1);} else {WAIT_BAR(0);} }while(0)
  for(;t+1<NT;t+=2){
    STEP(pB0,pB1,pA0,pA1,t,(t+3<NT),(t+1<NT),(t+1<NT));       ENDW(t);   RESC(); ROT();
    STEP(pA0,pA1,pB0,pB1,t+1,(t+4<NT),(t+2<NT),(t+2<NT));     ENDW(t+1); RESC(); ROT();
  }
  STEP(pB0,pB1,pA0,pA1,NT-1,false,false,false); RESC();
  { float sacc=pB0[0]+pB0[1]; _Pragma("unroll") for(int r=2;r<16;++r)sacc+=pB0[r]; _Pragma("unroll") for(int r=0;r<16;++r)sacc+=pB1[r]; l_reg+=sacc;
    pw0=(u32x4){PKW(pB0,0),PKW(pB0,2),PKW(pB0,4),PKW(pB0,6)};pw1=(u32x4){PKW(pB0,8),PKW(pB0,10),PKW(pB0,12),PKW(pB0,14)};pw2=(u32x4){PKW(pB1,0),PKW(pB1,2),PKW(pB1,4),PKW(pB1,6)};pw3=(u32x4){PKW(pB1,8),PKW(pB1,10),PKW(pB1,12),PKW(pB1,14)};
    SBAR(); pv(o,vb0+sl_cur,PAF(0),PAF(1),PAF(2),PAF(3)); }
  #undef PKW
  #undef PAF
  #undef VFR
  #undef PIN
  #undef MX3
  #undef GAPA
  #undef GAPB
  #undef EX
  #undef VRD
  #undef KRD
  #undef STEP
  #undef ENDW
  {auto rr=__builtin_amdgcn_permlane32_swap(__float_as_uint(l_reg),__float_as_uint(l_reg),false,false);l_reg=__uint_as_float(rr[0])+__uint_as_float(rr[1]);}
  if(hi==0)wsf[32+r32]=l_reg;asm volatile("s_waitcnt lgkmcnt(0)":::"memory");
  float rli[16];
  #pragma unroll
  for(int r=0;r<16;++r)rli[r]=__builtin_amdgcn_rcpf(wsf[32+crow(r,hi)]);
  bf16*Ow=O+(rowbase+q0+wid*QBLK)*DM+h*D;
  { bf16*stg=(bf16*)(shm+LDS_OST)+wid*2048;
    #pragma unroll
    for(int r=0;r<16;++r){const int orow=crow(r,hi);
      #pragma unroll
      for(int d0=0;d0<2;++d0)stg[orow*64+d0*32+r32]=(bf16)f2bf(o[d0][r]*rli[r]);}
    asm volatile("s_waitcnt lgkmcnt(0)":::"memory");
    #pragma unroll
    for(int i=0;i<4;++i){const int row=i*8+(lane>>3),ch=lane&7; const u32x4 v=*(const u32x4*)(stg+row*64+ch*8); ATTN_STORE16(Ow+(long)row*DM+ch*8,v);} }
  asm volatile("s_waitcnt lgkmcnt(0)\n\ts_barrier":::"memory");
  #undef DMA_K
  #undef DMA_V
  #undef NBADD
  #undef CMASK
  #undef START
  #undef RESC
  #undef ROT
}

#undef SBAR
#undef WAIT_BAR
}
#define XB_TMO      128
#define XB_XCNT(j)  (256  + 64 * (j))
#define XB_XSUB(j)  (1280 + 64 * (j))
#define XB_XGEN(j)  (2304 + 64 * (j))
#define XB_TOP      3328
#define XB_TOPGEN   3392
#define XCD_BAR_WORDS 3456
#define XB_SPIN_CAP (1u << 18)

__device__ __forceinline__ unsigned xb_ld(unsigned* p)              { return __hip_atomic_load(p, __ATOMIC_RELAXED, __HIP_MEMORY_SCOPE_AGENT); }
__device__ __forceinline__ unsigned xb_add(unsigned* p, unsigned v) { return __hip_atomic_fetch_add(p, v, __ATOMIC_RELAXED, __HIP_MEMORY_SCOPE_AGENT); }
__device__ __forceinline__ unsigned xb_xcc_id() { return (unsigned)__builtin_amdgcn_s_getreg((3 << 11) | 20) & 0xFu; }
#define XB_SPIN(cond, bar) do { unsigned _sp = 0; while (cond) { __builtin_amdgcn_s_sleep(1); \
    if ((++_sp & 255u) == 0u) { if (xb_ld(&(bar)[XB_TMO])) break; if (_sp > XB_SPIN_CAP) { atomicAdd(&(bar)[XB_TMO], 1u); break; } } } } while (0)

struct XcdBarrier {
    unsigned* bar; unsigned x;
    volatile LAS unsigned* st;
};

__device__ __forceinline__ XcdBarrier xcd_barrier_post(unsigned* bar, volatile LAS unsigned* st) {
    XcdBarrier b; b.bar = bar; b.x = xb_xcc_id(); b.st = st;
    if (threadIdx.x == 0) (void)xb_add(&bar[XB_XCNT(b.x)], 1u);
    return b;
}
__device__ __forceinline__ void xcd_barrier_complete(unsigned* bar, unsigned x, unsigned& nloc, unsigned& nx) {
    const unsigned G = gridDim.x * gridDim.y * gridDim.z;
    unsigned sum, cnt, mine, sp = 0u;
    for (;;) {
        sum = 0u; cnt = 0u; mine = 0u;
#pragma unroll
        for (unsigned j = 0; j < 16; ++j) { const unsigned c = xb_ld(&bar[XB_XCNT(j)]); sum += c; cnt += (c > 0u) ? 1u : 0u; mine = (j == x) ? c : mine; }
        if (sum == G) break;
        __builtin_amdgcn_s_sleep(1);
        if ((++sp & 255u) == 0u) { if (xb_ld(&bar[XB_TMO])) break; if (sp > XB_SPIN_CAP) { atomicAdd(&bar[XB_TMO], 1u); break; } }
    }
    nloc = mine > 0u ? mine : 1u; nx = cnt > 0u ? cnt : 1u;
}

__device__ __forceinline__ void xcd_barrier(const XcdBarrier& b) {
    asm volatile("s_waitcnt vmcnt(0)" ::: "memory");
    __syncthreads();
    if (threadIdx.x == 0) {
        unsigned* bar = b.bar;
        __builtin_amdgcn_s_waitcnt(0);
        unsigned nloc = b.st[0], nx = b.st[1];
        if (nloc == 0u) { xcd_barrier_complete(bar, b.x, nloc, nx); b.st[0] = nloc; b.st[1] = nx; }
        const unsigned old = xb_add(&bar[XB_XSUB(b.x)], 1u);
        const unsigned gen = old / nloc;
        if (old + 1u == (gen + 1u) * nloc) {
            __builtin_amdgcn_fence(__ATOMIC_RELEASE, "agent");
            asm volatile("s_waitcnt vmcnt(0)" ::: "memory");
            const unsigned og = xb_add(&bar[XB_TOP], 1u);
            const unsigned tg = og / nx;
            if (og + 1u == (tg + 1u) * nx) xb_add(&bar[XB_TOPGEN], 1u);
            else XB_SPIN(xb_ld(&bar[XB_TOPGEN]) == tg, bar);
            __builtin_amdgcn_fence(__ATOMIC_ACQUIRE, "agent");
            xb_add(&bar[XB_XGEN(b.x)], 1u);
            asm volatile("s_waitcnt vmcnt(0)" ::: "memory");
        } else {
            XB_SPIN(xb_ld(&bar[XB_XGEN(b.x)]) == gen, bar);
            __builtin_amdgcn_fence(__ATOMIC_ACQUIRE, "agent");
            asm volatile("s_waitcnt vmcnt(0)" ::: "memory");
        }
    }
    __syncthreads();
}
constexpr int NWAVES = 8;
struct Frame {
    LAS unsigned char* lds; volatile LAS unsigned* MISC; gu32* ctl; unsigned char* ws;
    int tid, lane, wave, G, bx;
    const float *x, *meta, *na, *wqkva, *woa, *nkv, *wkvf, *bfg, *kn, *nab, *wqb, *qnb, *wob, *nfd, *wgud, *wdnd, *nfm, *wrt, *wgum, *wdnm; float* out;
};
__device__ __forceinline__ float wave_sum(float v) {
#pragma unroll
    for (int o = 1; o < 64; o <<= 1) v += __shfl_xor(v, o);
    return v;
}
#ifndef FP8_P5
#define FP8_P5 1
#endif
template <bool FP8, bool GAIN, bool CM = false>
__device__ __forceinline__ void tr64(const float* W, int ld, int k0, int nsrc0, const float* gain, float qs, void* WT, int Kp, int drow0, LAS unsigned* scr, int lane, gu32* cmax = nullptr) {
    const int nq = lane & 15, kq = lane >> 4; float cm[4] = {0.f, 0.f, 0.f, 0.f};
    constexpr int KPL = FP8 ? 4 : 2, KI = FP8 ? 128 : 64, NR = KI / (4 * KPL), PITCH = KI / KPL + 1;
#pragma unroll
    for (int r = 0; r < NR; ++r) {
        const int k = k0 + (4 * r + kq) * KPL; f32x4 v[KPL]; float g[KPL];
#pragma unroll
        for (int j = 0; j < KPL; ++j) { v[j] = __builtin_nontemporal_load((const GAS f32x4*)(W + (size_t)(k + j) * ld + nsrc0 + 4 * nq)); if constexpr (GAIN) g[j] = gain[k + j] * qs; else g[j] = qs; }
#pragma unroll
        for (int j = 0; j < KPL; ++j) { v[j] = v[j] * g[j]; if constexpr (CM) {
#pragma unroll
            for (int i = 0; i < 4; ++i) cm[i] = fmaxf(cm[i], fabsf(v[j][i])); } }
#pragma unroll
        for (int i = 0; i < 4; ++i) { unsigned p; if constexpr (FP8) p = pk4_fp8(v[0][i], v[1][i], v[2][i], v[3][i]); else p = pk2(v[0][i], v[1][i]);
            scr[(4 * nq + i) * PITCH + 4 * r + kq] = p; }
    }
    if constexpr (CM) {
#pragma unroll
        for (int i = 0; i < 4; ++i) { float m_ = cm[i]; m_ = fmaxf(m_, __shfl_xor(m_, 16)); m_ = fmaxf(m_, __shfl_xor(m_, 32)); if (kq == 0) __hip_atomic_fetch_max(cmax + drow0 + 4 * nq + i, __builtin_bit_cast(unsigned, m_), RLX_AGENT); } }
    LDS_WAIT(); asm volatile("" ::: "memory");
    constexpr int LPR = 8, RPI = 64 / LPR, NJ = 64 / RPI;
    const int c = lane % LPR;
#pragma unroll
    for (int j = 0; j < NJ; ++j) { const int n = RPI * j + lane / LPR; const LAS unsigned* s = scr + n * PITCH + 4 * c; u32x4 o; o.x = s[0]; o.y = s[1]; o.z = s[2]; o.w = s[3];
        *(GAS u32x4*)((unsigned char*)WT + ((size_t)(drow0 + n) * Kp + k0) * (FP8 ? 1 : 2) + 16 * c) = o; }
    LDS_WAIT(); asm volatile("" ::: "memory");
}
__device__ __forceinline__ int gu_drow(int n0) { return (n0 < FF) ? (n0 / 128) * 256 + (n0 % 128) : ((n0 - FF) / 128) * 256 + 128 + ((n0 - FF) % 128); }
__device__ __forceinline__ void p0_prologue(Frame& F) {
    const int gw = F.bx * NWAVES + F.wave, NGW = F.G * NWAVES, lane = F.lane;
    unsigned char* ws = F.ws;
    constexpr int I_QKV0 = 16 * 48, I_O = 16 * 16, I_GU = 16 * 88, I_DN = 44 * 16, I_KV = 16 * 32;
    constexpr int I_GU8 = 8 * 88, I_DN8 = 22 * 16;
    constexpr int NITEMS = I_QKV0 + I_O + I_GU + I_DN + I_O + I_KV + I_O + NE * I_GU8 + NE * I_DN8 + (FP8_P5 ? I_DN8 : 0);
    LAS unsigned* scr = (LAS unsigned*)(F.lds + F.wave * 16384);
    for (int it = gw; it < NITEMS; it += NGW) {
        int r = it;
        if (r < I_QKV0) { tr64<false, true, true>(F.wqkva, 3 * DM, 64 * (r / 48), 64 * (r % 48), F.na, 1.f, ws + WS_WQKV0, DM, 64 * (r % 48), scr, lane, F.ctl + CM_QKV0); continue; } r -= I_QKV0;
        if (r < I_O) { tr64<false, false>(F.woa, DM, 64 * (r / 16), 64 * (r % 16), nullptr, 1.f, ws + WS_WO0, DM, 64 * (r % 16), scr, lane); continue; } r -= I_O;
        if (r < I_GU) { tr64<false, true, true>(F.wgud, 2 * FF, 64 * (r / 88), 64 * (r % 88), F.nfd, 1.f, ws + WS_WGU0, DM, gu_drow(64 * (r % 88)), scr, lane, F.ctl + CM_GU0); continue; } r -= I_GU;
        if (r < I_DN) { tr64<false, false>(F.wdnd, DM, 64 * (r / 16), 64 * (r % 16), nullptr, 1.f, ws + WS_WDN0, FF, 64 * (r % 16), scr, lane); continue; } r -= I_DN;
        if (r < I_O) { tr64<false, true, true>(F.wqb, DM, 64 * (r / 16), 64 * (r % 16), F.nab, 1.f, ws + WS_WQKV1, DM, 64 * (r % 16), scr, lane, F.ctl + CM_QKV1); continue; } r -= I_O;
        if (r < I_KV) { tr64<false, true, true>(F.wkvf, 2 * DM + NH, 64 * (r / 32), 64 * (r % 32), F.nkv, 1.f, ws + WS_WQKV1, DM, DM + 64 * (r % 32), scr, lane, F.ctl + CM_QKV1); continue; } r -= I_KV;
        if (r < I_O) { tr64<false, false>(F.wob, DM, 64 * (r / 16), 64 * (r % 16), nullptr, 1.f, ws + WS_WO1, DM, 64 * (r % 16), scr, lane); continue; } r -= I_O;
        if (r < NE * I_GU8) { const int e = r / I_GU8, i2 = r % I_GU8;
            tr64<true, true>(F.wgum + (size_t)e * DM * 2 * FF, 2 * FF, 128 * (i2 / 88), 64 * (i2 % 88), F.nfm, QS_WGU, ws + WS_WGU1 + (size_t)e * 2 * FF * DM, DM, gu_drow(64 * (i2 % 88)), scr, lane); continue; } r -= NE * I_GU8;
        if (r < NE * I_DN8) { const int e = r / I_DN8, i2 = r % I_DN8;
            tr64<true, false>(F.wdnm + (size_t)e * FF * DM, DM, 128 * (i2 / 16), 64 * (i2 % 16), nullptr, QS_WDN, ws + WS_WDN1 + (size_t)e * DM * FF, FF, 64 * (i2 % 16), scr, lane); continue; } r -= NE * I_DN8;
        tr64<true, false>(F.wdnd, DM, 128 * (r / 16), 64 * (r % 16), nullptr, QS_WDN, ws + WS_WDN0Q, FF, 64 * (r % 16), scr, lane);
    }
    { bf16* WF = (bf16*)(ws + WS_WSM); bf16* WR = (bf16*)(ws + WS_WSM + 32768);
        for (int i = gw * 64 + lane; i < 16 * DM; i += NGW * 64) { const int n = i >> 10, k = i & 1023;
            WF[i] = (bf16)f2bf(F.wkvf[(size_t)k * (2 * DM + NH) + 2 * DM + n] * F.nkv[k]);
            const float v = F.wrt[(size_t)k * NE + (n & 7)] * F.nfm[k]; const unsigned hb = f2bf(v); const float hv = __builtin_bit_cast(float, hb << 16);
            WR[i] = (bf16)((n < 8) ? hb : f2bf(v - hv)); } }
    { bf16* H = (bf16*)(ws + WS_H); u64* ss0 = (u64*)(ws + WS_SS0); float* ra0 = (float*)(ws + WS_RA0);
        for (int m = gw; m < T; m += NGW) { const GAS f32x4* xr = (const GAS f32x4*)(F.x + (size_t)m * DM) + lane; f32x4 v[4]; float s = 0.f, mx = 0.f;
#pragma unroll
            for (int j = 0; j < 4; ++j) { v[j] = __builtin_nontemporal_load(xr + 64 * j); s += (v[j].x * v[j].x + v[j].y * v[j].y) + (v[j].z * v[j].z + v[j].w * v[j].w);
                mx = fmaxf(fmaxf(mx, fmaxf(fabsf(v[j].x), fabsf(v[j].y))), fmaxf(fabsf(v[j].z), fabsf(v[j].w))); }
            s = wave_sum(s);
#pragma unroll
            for (int o = 1; o < 64; o <<= 1) mx = fmaxf(mx, __shfl_xor(mx, o));
            if (lane == 0) { ss0[m] = to_fx(s); ra0[m] = frsq(s * (1.f / DM) + EPS) * (mx * (1.f / 127.f)); }
            { const float qi = mx > 0.f ? 127.f / mx : 0.f; GAS unsigned* o4 = (GAS unsigned*)(ws + WS_H8 + (size_t)m * DM) + lane;
#pragma unroll
                for (int j = 0; j < 4; ++j) o4[64 * j] = pk4_i8(v[j].x * qi, v[j].y * qi, v[j].z * qi, v[j].w * qi); }
            GAS unsigned long long* o8 = (GAS unsigned long long*)(H + (size_t)m * DM) + lane;
#pragma unroll
            for (int j = 0; j < 4; ++j) o8[64 * j] = (unsigned long long)pk2(v[j].x, v[j].y) | ((unsigned long long)pk2(v[j].z, v[j].w) << 32); } }
    { GAS u32x4* z = (GAS u32x4*)(ws + Z_SS1); const int nz = (int)((Z_KSQM + 2048 - Z_SS1) / 16); for (int i = gw * 64 + lane; i < nz; i += NGW * 64) z[i] = (u32x4){0u, 0u, 0u, 0u}; }
    { for (int m = gw; m < 2 * NB * 48; m += NGW) { const int which = m / (NB * 48), rr = m % (NB * 48), b = rr / 48, kr = rr % 48;
            GAS u32x4* p = (GAS u32x4*)(ws + (which ? WS_V : WS_K) + ((size_t)b * KROWS + kr) * DM * 2) + lane; p[0] = (u32x4){0u, 0u, 0u, 0u}; p[64] = (u32x4){0u, 0u, 0u, 0u}; } }
}

template <bool PERM = false>
__device__ __forceinline__ void quant_rows_i8(Frame& F, const bf16* src, unsigned char* dst, const gu32* cmax, int R, int rb = 0) {
    const int gwv = F.bx * NWAVES + F.wave, NGW = F.G * NWAVES;
    for (int r0 = rb + gwv; r0 < R; r0 += 4 * NGW) {
        u32x4 a[4], b[4]; unsigned mxb[4];
#pragma unroll
        for (int q = 0; q < 4; ++q) { const int r = r0 + q * NGW; const int rc = r < R ? r : r0;
            mxb[q] = __hip_atomic_load(cmax + rc, RLX_AGENT); const GAS u32x4* s = (const GAS u32x4*)(src + (size_t)rc * DM) + 2 * F.lane; a[q] = s[0]; b[q] = s[1]; }
#pragma unroll
        for (int q = 0; q < 4; ++q) { const int r = r0 + q * NGW; if (r >= R) break;
            const float mx = __builtin_bit_cast(float, mxb[q]); const float qi = mx > 0.f ? 127.f / mx : 0.f; u32x4 o;
            o.x = pk4_i8(bflo(a[q].x) * qi, bfhi(a[q].x) * qi, bflo(a[q].y) * qi, bfhi(a[q].y) * qi); o.y = pk4_i8(bflo(a[q].z) * qi, bfhi(a[q].z) * qi, bflo(a[q].w) * qi, bfhi(a[q].w) * qi);
            o.z = pk4_i8(bflo(b[q].x) * qi, bfhi(b[q].x) * qi, bflo(b[q].y) * qi, bfhi(b[q].y) * qi); o.w = pk4_i8(bflo(b[q].z) * qi, bfhi(b[q].z) * qi, bflo(b[q].w) * qi, bfhi(b[q].w) * qi);
            const int rd = PERM ? ((r & ~255) | (((r >> 5) & 1) << 7) | (((r >> 6) & 3) << 5) | (r & 31)) : r;
            *((GAS u32x4*)(dst + (size_t)rd * DM) + F.lane) = o; }
    }
}
struct QR { u32x4 a[4], b[4]; unsigned mx[4]; };
__device__ __forceinline__ void qr_issue(Frame& F, const bf16* src, const gu32* cmax, int R, QR& q) {
    const int gwv = F.bx * NWAVES + F.wave, NGW = F.G * NWAVES;
#pragma unroll
    for (int i = 0; i < 4; ++i) { const int r = gwv + i * NGW; const int rc = r < R ? r : (gwv < R ? gwv : 0);
        q.mx[i] = __hip_atomic_load(cmax + rc, RLX_AGENT); const GAS u32x4* s = (const GAS u32x4*)(src + (size_t)rc * DM) + 2 * F.lane; q.a[i] = s[0]; q.b[i] = s[1]; }
}
template <bool PERM>
__device__ __forceinline__ void qr_finish(Frame& F, unsigned char* dst, int R, const QR& q) {
    const int gwv = F.bx * NWAVES + F.wave, NGW = F.G * NWAVES;
#pragma unroll
    for (int i = 0; i < 4; ++i) { const int r = gwv + i * NGW; if (r >= R) break;
        const float mx = __builtin_bit_cast(float, q.mx[i]); const float qi = mx > 0.f ? 127.f / mx : 0.f; u32x4 o;
        o.x = pk4_i8(bflo(q.a[i].x) * qi, bfhi(q.a[i].x) * qi, bflo(q.a[i].y) * qi, bfhi(q.a[i].y) * qi); o.y = pk4_i8(bflo(q.a[i].z) * qi, bfhi(q.a[i].z) * qi, bflo(q.a[i].w) * qi, bfhi(q.a[i].w) * qi);
        o.z = pk4_i8(bflo(q.b[i].x) * qi, bfhi(q.b[i].x) * qi, bflo(q.b[i].y) * qi, bfhi(q.b[i].y) * qi); o.w = pk4_i8(bflo(q.b[i].z) * qi, bfhi(q.b[i].z) * qi, bflo(q.b[i].w) * qi, bfhi(q.b[i].w) * qi);
        const int rd = PERM ? ((r & ~255) | (((r >> 5) & 1) << 7) | (((r >> 6) & 3) << 5) | (r & 31)) : r;
        *((GAS u32x4*)(dst + (size_t)rd * DM) + F.lane) = o; }
}
__device__ __forceinline__ void meta_stage_norm(Frame& F, const float* src  ) {
    LAS bf16* xm = (LAS bf16*)F.lds;
    const int r = F.tid >> 5, c0 = 4 * (F.tid & 31); f32x4 v[8]; float s = 0.f;
#pragma unroll
    for (int j = 0; j < 8; ++j) { v[j] = *(const GAS f32x4*)(src + r * DM + c0 + 128 * j); s += (v[j].x * v[j].x + v[j].y * v[j].y) + (v[j].z * v[j].z + v[j].w * v[j].w); }
#pragma unroll
    for (int o = 1; o < 32; o <<= 1) s += __shfl_xor(s, o);
    const float rs = frsq(s * (1.f / DM) + EPS);
#pragma unroll
    for (int j = 0; j < 8; ++j) { u32x2 o2; o2.x = pk2(v[j].x * rs, v[j].y * rs); o2.y = pk2(v[j].z * rs, v[j].w * rs); *(LAS u32x2*)(xm + r * DM + c0 + 128 * j) = o2; }
    __syncthreads();
}
template <int N>
__device__ __forceinline__ void meta_stage_bf16(Frame& F, const bf16* src) {
    LAS u32x4* xm = (LAS u32x4*)F.lds; const GAS u32x4* s = (const GAS u32x4*)src;
    constexpr int NV = N / 8, NI = (NV + NWAVES * 64 - 1) / (NWAVES * 64);
    u32x4 v[NI];
#pragma unroll
    for (int j = 0; j < NI; ++j) { const int i = F.tid + j * NWAVES * 64; v[j] = s[i < NV ? i : F.tid]; }
#pragma unroll
    for (int j = 0; j < NI; ++j) { const int i = F.tid + j * NWAVES * 64; if (i < NV) xm[i] = v[j]; }
    __syncthreads();
}
__device__ __forceinline__ int mrow_of(int lane) { return ((lane >> 5) & 1) * 8 + ((lane >> 4) & 1) * 4 + ((lane >> 3) & 1) * 2 + ((lane >> 2) & 1); }
__device__ __forceinline__ float meta_dot(const bf16* wrow, const LAS bf16* xm, int K, int lane) {
    float a[16];
#pragma unroll
    for (int r = 0; r < 16; ++r) a[r] = 0.f;
    for (int k = lane * 8; k < K; k += 512) {
        const u32x4 w = *(const GAS u32x4*)(wrow + k);
        const float w0 = bflo(w.x), w1 = bfhi(w.x), w2 = bflo(w.y), w3 = bfhi(w.y), w4 = bflo(w.z), w5 = bfhi(w.z), w6 = bflo(w.w), w7 = bfhi(w.w);
#pragma unroll
        for (int r = 0; r < 16; ++r) { const u32x4 x = *(const LAS u32x4*)(xm + (size_t)r * K + k);
            a[r] += (w0 * bflo(x.x) + w1 * bfhi(x.x)) + (w2 * bflo(x.y) + w3 * bfhi(x.y)) + (w4 * bflo(x.z) + w5 * bfhi(x.z)) + (w6 * bflo(x.w) + w7 * bfhi(x.w)); }
    }
    float b8[8], b4[4], b2[2], b1;
#pragma unroll
    for (int i = 0; i < 8; ++i) { const bool up = (lane & 32) != 0; const float keep = up ? a[i + 8] : a[i], send = up ? a[i] : a[i + 8]; b8[i] = keep + __shfl_xor(send, 32); }
#pragma unroll
    for (int i = 0; i < 4; ++i) { const bool up = (lane & 16) != 0; const float keep = up ? b8[i + 4] : b8[i], send = up ? b8[i] : b8[i + 4]; b4[i] = keep + __shfl_xor(send, 16); }
#pragma unroll
    for (int i = 0; i < 2; ++i) { const bool up = (lane & 8) != 0; const float keep = up ? b4[i + 2] : b4[i], send = up ? b4[i] : b4[i + 2]; b2[i] = keep + __shfl_xor(send, 8); }
    { const bool up = (lane & 4) != 0; const float keep = up ? b2[1] : b2[0], send = up ? b2[0] : b2[1]; b1 = keep + __shfl_xor(send, 4); }
    b1 += __shfl_xor(b1, 2); b1 += __shfl_xor(b1, 1);
    return b1;
}
__device__ __forceinline__ void md2_load(const bf16* wrow, int lane, u32x4& wv0, u32x4& wv1) { wv0 = *(const GAS u32x4*)(wrow + lane * 8); wv1 = *(const GAS u32x4*)(wrow + lane * 8 + 512); }
__device__ __forceinline__ float md2_comp(const u32x4 wv0, const u32x4 wv1, const LAS bf16* xm, int lane) {
    float a[16];
#pragma unroll
    for (int r = 0; r < 16; ++r) a[r] = 0.f;
#pragma unroll
    for (int c = 0; c < 2; ++c) { const int k = lane * 8 + 512 * c; const u32x4 w = c ? wv1 : wv0;
        const float w0 = bflo(w.x), w1 = bfhi(w.x), w2 = bflo(w.y), w3 = bfhi(w.y), w4 = bflo(w.z), w5 = bfhi(w.z), w6 = bflo(w.w), w7 = bfhi(w.w);
#pragma unroll
        for (int r = 0; r < 16; ++r) { const u32x4 x = *(const LAS u32x4*)(xm + (size_t)r * DM + k);
            a[r] += (w0 * bflo(x.x) + w1 * bfhi(x.x)) + (w2 * bflo(x.y) + w3 * bfhi(x.y)) + (w4 * bflo(x.z) + w5 * bfhi(x.z)) + (w6 * bflo(x.w) + w7 * bfhi(x.w)); }
        asm volatile("" ::: "memory"); }
    float b8[8], b4[4], b2[2], b1;
#pragma unroll
    for (int i = 0; i < 8; ++i) { const bool up = (lane & 32) != 0; const float keep = up ? a[i + 8] : a[i], send = up ? a[i] : a[i + 8]; b8[i] = keep + __shfl_xor(send, 32); }
#pragma unroll
    for (int i = 0; i < 4; ++i) { const bool up = (lane & 16) != 0; const float keep = up ? b8[i + 4] : b8[i], send = up ? b8[i] : b8[i + 4]; b4[i] = keep + __shfl_xor(send, 16); }
#pragma unroll
    for (int i = 0; i < 2; ++i) { const bool up = (lane & 8) != 0; const float keep = up ? b4[i + 2] : b4[i], send = up ? b4[i] : b4[i + 2]; b2[i] = keep + __shfl_xor(send, 8); }
    { const bool up = (lane & 4) != 0; const float keep = up ? b2[1] : b2[0], send = up ? b2[0] : b2[1]; b1 = keep + __shfl_xor(send, 4); }
    b1 += __shfl_xor(b1, 2); b1 += __shfl_xor(b1, 1);
    return b1;
}
__device__ __forceinline__ float meta_dot2(const bf16* wrow, const LAS bf16* xm, int lane) { u32x4 a, b; md2_load(wrow, lane, a, b); return md2_comp(a, b, xm, lane); }
struct W22 { u32x4 g0, g1, u0, u1; };
__device__ __forceinline__ W22 md22_load(const bf16* wg, const bf16* wu, int lane) { W22 w; w.g0 = *(const GAS u32x4*)(wg + lane * 8); w.g1 = *(const GAS u32x4*)(wg + lane * 8 + 512); w.u0 = *(const GAS u32x4*)(wu + lane * 8); w.u1 = *(const GAS u32x4*)(wu + lane * 8 + 512); return w; }
__device__ __forceinline__ void md22_comp(const W22 ww, const LAS bf16* xm, int lane, float& og, float& ou) {
    float a[16], c[16];
#pragma unroll
    for (int r = 0; r < 16; ++r) { a[r] = 0.f; c[r] = 0.f; }
    const u32x4 g0 = ww.g0, g1 = ww.g1, u0 = ww.u0, u1 = ww.u1;
#pragma unroll
    for (int ch = 0; ch < 2; ++ch) { const int k = lane * 8 + 512 * ch; const u32x4 w = ch ? g1 : g0, z = ch ? u1 : u0;
        const float w0 = bflo(w.x), w1 = bfhi(w.x), w2 = bflo(w.y), w3 = bfhi(w.y), w4 = bflo(w.z), w5 = bfhi(w.z), w6 = bflo(w.w), w7 = bfhi(w.w);
        const float z0 = bflo(z.x), z1 = bfhi(z.x), z2 = bflo(z.y), z3 = bfhi(z.y), z4 = bflo(z.z), z5 = bfhi(z.z), z6 = bflo(z.w), z7 = bfhi(z.w);
#pragma unroll
        for (int r = 0; r < 16; ++r) { const u32x4 x = *(const LAS u32x4*)(xm + (size_t)r * DM + k);
            const float x0 = bflo(x.x), x1 = bfhi(x.x), x2 = bflo(x.y), x3 = bfhi(x.y), x4 = bflo(x.z), x5 = bfhi(x.z), x6 = bflo(x.w), x7 = bfhi(x.w);
            a[r] += (w0 * x0 + w1 * x1) + (w2 * x2 + w3 * x3) + (w4 * x4 + w5 * x5) + (w6 * x6 + w7 * x7);
            c[r] += (z0 * x0 + z1 * x1) + (z2 * x2 + z3 * x3) + (z4 * x4 + z5 * x5) + (z6 * x6 + z7 * x7); }
        asm volatile("" ::: "memory"); }
#pragma unroll
    for (int pass = 0; pass < 2; ++pass) { float b8[8], b4[4], b2[2], b1;
#pragma unroll
        for (int i = 0; i < 8; ++i) { const bool up = (lane & 32) != 0; const float lo_ = pass ? c[i] : a[i], hi_ = pass ? c[i + 8] : a[i + 8]; const float keep = up ? hi_ : lo_, send = up ? lo_ : hi_; b8[i] = keep + __shfl_xor(send, 32); }
#pragma unroll
        for (int i = 0; i < 4; ++i) { const bool up = (lane & 16) != 0; const float keep = up ? b8[i + 4] : b8[i], send = up ? b8[i] : b8[i + 4]; b4[i] = keep + __shfl_xor(send, 16); }
#pragma unroll
        for (int i = 0; i < 2; ++i) { const bool up = (lane & 8) != 0; const float keep = up ? b4[i + 2] : b4[i], send = up ? b4[i] : b4[i + 2]; b2[i] = keep + __shfl_xor(send, 8); }
        { const bool up = (lane & 4) != 0; const float keep = up ? b2[1] : b2[0], send = up ? b2[0] : b2[1]; b1 = keep + __shfl_xor(send, 4); }
        b1 += __shfl_xor(b1, 2); b1 += __shfl_xor(b1, 1);
        if (pass) ou = b1; else og = b1; }
}
struct W6 { u32x4 w[6]; };
__device__ __forceinline__ W6 mdff_load(const bf16* wrow, int lane) { W6 q;
#pragma unroll
    for (int c = 0; c < 6; ++c) { const int k = lane * 8 + 512 * c; q.w[c] = (k < FF) ? *(const GAS u32x4*)(wrow + k) : (u32x4){0u, 0u, 0u, 0u}; }
    return q; }
__device__ __forceinline__ float mdff_comp(const W6 q, const LAS bf16* xm, int lane) {
    float a[16];
#pragma unroll
    for (int r = 0; r < 16; ++r) a[r] = 0.f;
    u32x4 wv[6];
#pragma unroll
    for (int c = 0; c < 6; ++c) wv[c] = q.w[c];
#pragma unroll
    for (int c = 0; c < 6; ++c) { const int k = lane * 8 + 512 * c; const int kc = k < FF ? k : 0; const u32x4 w = wv[c];
        const float w0 = bflo(w.x), w1 = bfhi(w.x), w2 = bflo(w.y), w3 = bfhi(w.y), w4 = bflo(w.z), w5 = bfhi(w.z), w6 = bflo(w.w), w7 = bfhi(w.w);
#pragma unroll
        for (int r = 0; r < 16; ++r) { const u32x4 x = *(const LAS u32x4*)(xm + (size_t)r * FF + kc);
            a[r] += (w0 * bflo(x.x) + w1 * bfhi(x.x)) + (w2 * bflo(x.y) + w3 * bfhi(x.y)) + (w4 * bflo(x.z) + w5 * bfhi(x.z)) + (w6 * bflo(x.w) + w7 * bfhi(x.w)); }
        asm volatile("" ::: "memory"); }
    float b8[8], b4[4], b2[2], b1;
#pragma unroll
    for (int i = 0; i < 8; ++i) { const bool up = (lane & 32) != 0; const float keep = up ? a[i + 8] : a[i], send = up ? a[i] : a[i + 8]; b8[i] = keep + __shfl_xor(send, 32); }
#pragma unroll
    for (int i = 0; i < 4; ++i) { const bool up = (lane & 16) != 0; const float keep = up ? b8[i + 4] : b8[i], send = up ? b8[i] : b8[i + 4]; b4[i] = keep + __shfl_xor(send, 16); }
#pragma unroll
    for (int i = 0; i < 2; ++i) { const bool up = (lane & 8) != 0; const float keep = up ? b4[i + 2] : b4[i], send = up ? b4[i] : b4[i + 2]; b2[i] = keep + __shfl_xor(send, 8); }
    { const bool up = (lane & 4) != 0; const float keep = up ? b2[1] : b2[0], send = up ? b2[0] : b2[1]; b1 = keep + __shfl_xor(send, 4); }
    b1 += __shfl_xor(b1, 2); b1 += __shfl_xor(b1, 1);
    return b1;
}
__device__ __forceinline__ float silu_f(float g) { return g * frcp(1.f + fexp2(-g * LOG2E)); }

__device__ __forceinline__ f32x4 skinny16(const bf16* Arow0, const bf16* W16, int fr, int fq) {
    f32x4 acc = {0.f, 0.f, 0.f, 0.f};
    const bf16x8* ap = (const bf16x8*)(Arow0 + (size_t)fr * DM + fq * 8);
    const bf16x8* wp = (const bf16x8*)(W16 + (size_t)fr * DM + fq * 8);
    bf16x8 a0[8], w0[8], a1[8], w1[8];
#define SK_LD(a, w, base) _Pragma("unroll") for (int j = 0; j < 8; ++j) { a[j] = ap[((base) + j) * 4]; w[j] = wp[((base) + j) * 4]; }
#define SK_MM(a, w) _Pragma("unroll") for (int j = 0; j < 8; ++j) acc = __builtin_amdgcn_mfma_f32_16x16x32_bf16(w[j], a[j], acc, 0, 0, 0);
    SK_LD(a0, w0, 0) SK_LD(a1, w1, 8)
    SK_MM(a0, w0) SK_LD(a0, w0, 16)
    SK_MM(a1, w1) SK_LD(a1, w1, 24)
    SK_MM(a0, w0) SK_MM(a1, w1)
#undef SK_LD
#undef SK_MM
    return acc;
}

__device__ __forceinline__ int moe_tables(Frame& F) {
    LAS int* tab = (LAS int*)(F.lds + L_TAB);
    if (F.tid < NE) { int c = (int)__hip_atomic_load(F.ctl + CW_CNT + 64 * F.tid, RLX_AGENT); c = c < 0 ? 0 : (c > T ? T : c); tab[288 + F.tid] = c; }
    __syncthreads();
    if (F.tid == 0) { int base = 0; for (int e = 0; e < NE; ++e) { tab[272 + e] = base; base += (tab[288 + e] + 255) >> 8; } tab[272 + NE] = base; }
    __syncthreads();
    if (F.tid < 272) { int e = 0;
#pragma unroll
        for (int k = 1; k < NE; ++k) e += (F.tid >= tab[272 + k]) ? 1 : 0;
        if (F.tid < tab[272 + NE]) tab[F.tid] = e; }
    __syncthreads();
    return tab[272 + NE];
}
constexpr int NPHASE = 13;
constexpr size_t WS_PLX = FP8_P5 ? WS_PL : 16 * MiB;
#ifndef I8_P4
#define I8_P4 1
#endif
#define LASTREP(k) (args.dry != (k))
struct Args { const float* in[20]; float* out; unsigned char* ws; int ph_lo, ph_hi, li, dry; };
__global__ void __launch_bounds__(NWAVES * 64, 2) yoco_fwd(Args args) {
    extern __shared__ __attribute__((aligned(16))) unsigned char lds_raw[];
    Frame F;
    F.lds = (LAS unsigned char*)lds_raw;
#if SATMODE
    asm volatile("s_setreg_imm32_b32 hwreg(HW_REG_MODE, 23, 1), 1\n\ts_nop 7" ::: "memory");
    bool sat_bad; { float big = 1000.f; asm volatile("" : "+v"(big)); const int p_ = __builtin_amdgcn_cvt_pk_fp8_f32(big, -big, 0, false); sat_bad = (p_ & 0xffff) != 0xFE7E; }
#endif
    F.MISC = (volatile LAS unsigned*)(F.lds + L_MISC);
    F.tid = threadIdx.x; F.lane = F.tid & 63; F.wave = __builtin_amdgcn_readfirstlane(F.tid >> 6);
    F.G = gridDim.x; F.bx = blockIdx.x;
    unsigned char* ws = args.ws; F.ws = ws;
    F.ctl = (gu32*)ws;
    F.x = args.in[0]; F.meta = args.in[1]; F.na = args.in[2]; F.wqkva = args.in[3]; F.woa = args.in[4]; F.nkv = args.in[5]; F.wkvf = args.in[6]; F.bfg = args.in[7]; F.kn = args.in[8];
    F.nab = args.in[9]; F.wqb = args.in[10]; F.qnb = args.in[11]; F.wob = args.in[12]; F.nfd = args.in[13]; F.wgud = args.in[14]; F.wdnd = args.in[15]; F.nfm = args.in[16]; F.wrt = args.in[17];
    F.wgum = args.in[18]; F.wdnm = args.in[19]; F.out = args.out;
    for (int u = F.tid; u < 64; u += NWAVES * 64) ((LAS unsigned*)(F.lds + L_MISC))[u] = 0u;
    __syncthreads();
    const int lo = args.ph_lo, hi = args.ph_hi;
    XcdBarrier bar; bar.bar = (unsigned*)(F.ctl + CW_BAR) + args.li * XCD_BAR_WORDS; bar.x = 0; bar.st = nullptr;
    if (hi - lo > 1) bar = xcd_barrier_post((unsigned*)(F.ctl + CW_BAR) + args.li * XCD_BAR_WORDS, F.MISC + 8);
#define IN(k) (lo <= (k) && (k) < hi)
#define SEAM(k) do { if (IN(k) && IN((k) + 1)) xcd_barrier(bar); } while (0)
    bf16* const Hb = (bf16*)(ws + WS_H); bf16* const Qb = (bf16*)(ws + WS_Q); bf16* const Ob = (bf16*)(ws + WS_ACT);
    bf16* const Kb = (bf16*)(ws + WS_K); bf16* const Vb = (bf16*)(ws + WS_V);
    u64* const SS0 = (u64*)(ws + WS_SS0); u64* const SS1 = (u64*)(ws + Z_SS1); u64* const SS2 = (u64*)(ws + Z_SS2); u64* const SS3 = (u64*)(ws + Z_SS3);
    u64* const KSQM = (u64*)(ws + Z_KSQM); float* const LF = (float*)(ws + WS_LF);
    unsigned char* const MT = ws + WS_META;
    bf16* const QM = (bf16*)(MT + MO_QM); bf16* const KM = (bf16*)(MT + MO_KM); bf16* const VM = (bf16*)(MT + MO_VM); bf16* const OM = (bf16*)(MT + MO_OM);
    float* const M1 = (float*)(MT + MO_M1); float* const M2 = (float*)(MT + MO_M2); bf16* const ACTM = (bf16*)(MT + MO_ACTM); float* const KMRAW = (float*)(MT + MO_KMRAW);
    const LAS bf16* const xm = (const LAS bf16*)F.lds;
    const int bx = F.bx, G = F.G;
#define PHASE_IDS() { int t_ = threadIdx.x; asm volatile("" : "+v"(t_)); F.tid = t_; F.lane = t_ & 63; F.wave = __builtin_amdgcn_readfirstlane(t_ >> 6); } const int lane = F.lane, wave = F.wave; const bool mlane = (lane & 3) == 0; const int mr = mrow_of(lane); (void)wave; (void)mlane; (void)mr

    if (IN(0)) { PHASE_IDS(); p0_prologue(F); }
    SEAM(0);
    if (IN(1)) { PHASE_IDS();
        QR qr0; qr_issue(F, (const bf16*)(ws + WS_WQKV0), F.ctl + CM_QKV0, 3 * DM, qr0);
        u32x4 mwa, mwb; md2_load((const bf16*)(ws + WS_WQKV0) + (size_t)((bx + G * wave) % (3 * DM)) * DM, lane, mwa, mwb);
        meta_stage_norm(F, F.meta);
        for (int c = bx + G * wave; c < 3 * DM; c += G * NWAVES) {
            const float v = md2_comp(mwa, mwb, xm, lane); if (c + G * NWAVES < 3 * DM) md2_load((const bf16*)(ws + WS_WQKV0) + (size_t)(c + G * NWAVES) * DM, lane, mwa, mwb);
            if (mlane) { const int sect = c >> 10, cc = c & 1023;
                if (sect == 0) QM[mr * DM + cc] = (bf16)f2bf(v * (-C2));
                else { const bf16 bv = (bf16)f2bf(v); (sect == 1 ? KM : VM)[mr * DM + cc] = bv; bf16* dst = (sect == 1 ? Kb : Vb) + (size_t)(48 + mr) * DM + cc;
                    for (int b = 0; b < NB; ++b) dst[(size_t)b * KROWS * DM] = bv; } }
        }
        qr_finish<false>(F, ws + WS_WQKV0Q, 3 * DM, qr0); if (4 * G * NWAVES < 3 * DM) quant_rows_i8(F, (const bf16*)(ws + WS_WQKV0), ws + WS_WQKV0Q, F.ctl + CM_QKV0, 3 * DM, 4 * G * NWAVES);
        if (hi - lo > 1) xcd_barrier(bar); else __syncthreads();
        pg8::DenseSched S{T / 256, 12, G, bx, (const char*)(ws + WS_H8), (const char*)(ws + WS_WQKV0Q), (size_t)256 * DM, (size_t)256 * DM};
        pg8::EpiQKV0I8 E{Qb, Kb, Vb, (const float*)(ws + WS_RA0), (const unsigned*)(F.ctl + CM_QKV0), -C2};
        pg8::gemm_phase<pg8::EpiQKV0I8, pg8::DenseSched, true, 2, 16>(F.lds, DM, S, E);
    }
    SEAM(1);
    if (IN(2)) { PHASE_IDS();
        if (bx < NH) {
            LAS float* be = (LAS float*)F.lds; LAS float* we = be + 256; LAS bf16* qs = (LAS bf16*)(F.lds + 2048); LAS bf16* ks = qs + 1024; LAS bf16* vs = ks + 1024;
            if (F.tid < 384) { const int which = F.tid >> 7, i = F.tid & 127, r = i >> 3, c = i & 7;
                const bf16* src = (which == 0 ? QM : which == 1 ? KM : VM) + r * DM + bx * HD + c * 8;
                *(LAS u32x4*)((which == 0 ? qs : which == 1 ? ks : vs) + r * 64 + c * 8) = *(const GAS u32x4*)src; }
            __syncthreads();
            if (F.tid < 256) { const int t = F.tid >> 4, s = F.tid & 15; float z = 0.f;
#pragma unroll 8
                for (int d = 0; d < HD; ++d) z += bf2f(qs[t * 64 + d]) * bf2f(ks[s * 64 + d]);
                const float e = fexp2(fminf(z, 80.f)); float b_ = frcp(1.f + e), w_ = e * b_; if (s >= t) { b_ = 0.f; w_ = 1.f; } be[F.tid] = b_; we[F.tid] = w_; }
            __syncthreads();
            for (int i = F.tid; i < 16 * HD; i += NWAVES * 64) { const int t = i >> 6, d = i & 63; float run = 1.f, o = 0.f;
                for (int s = t - 1; s >= 0; --s) { o += be[t * 16 + s] * run * bf2f(vs[s * 64 + d]); run *= we[t * 16 + s]; }
                OM[t * DM + bx * HD + d] = (bf16)f2bf(o); }
            __syncthreads();
        }
        for (int bh = bx; bh < NB * NH; bh += G)
            for (int qb = 0; qb < SEQ / 256; ++qb) att::sb_unit_win(bh >> 4, bh & 15, qb, Qb, Kb, Vb, Ob, F.lds);
        __syncthreads();
    }
    SEAM(2);
    if (IN(3)) { PHASE_IDS();
        QR qr1, qr2; qr_issue(F, (const bf16*)(ws + WS_WGU0), F.ctl + CM_GU0, 2 * FF, qr1); qr_issue(F, (const bf16*)(ws + WS_WQKV1), F.ctl + CM_QKV1, 3 * DM, qr2);
        const int c3 = bx + G * wave; u32x4 mwa, mwb; float mres = 0.f;
        if (c3 < DM) { md2_load((const bf16*)(ws + WS_WO0) + (size_t)c3 * DM, lane, mwa, mwb); mres = F.meta[mr * DM + c3]; }
        meta_stage_bf16<16 * DM>(F, OM);
        for (int c = c3; c < DM; c += G * NWAVES) {
            if (c != c3) { md2_load((const bf16*)(ws + WS_WO0) + (size_t)c * DM, lane, mwa, mwb); mres = F.meta[mr * DM + c]; }
            const float v = md2_comp(mwa, mwb, xm, lane);
            if (mlane) M1[mr * DM + c] = mres + v; }
        qr_finish<false>(F, ws + WS_WGU0Q, 2 * FF, qr1); if (4 * G * NWAVES < 2 * FF) quant_rows_i8(F, (const bf16*)(ws + WS_WGU0), ws + WS_WGU0Q, F.ctl + CM_GU0, 2 * FF, 4 * G * NWAVES);
        qr_finish<true>(F, ws + WS_WQKV1Q, 3 * DM, qr2); if (4 * G * NWAVES < 3 * DM) quant_rows_i8<true>(F, (const bf16*)(ws + WS_WQKV1), ws + WS_WQKV1Q, F.ctl + CM_QKV1, 3 * DM, 4 * G * NWAVES);
        __syncthreads();
        pg8::DenseSched S{T / 256, 4, G, bx, (const char*)Ob, (const char*)(ws + WS_WO0), (size_t)256 * DM * 2, (size_t)256 * DM * 2};
        pg8::EpiResidT<2> E{Hb, LASTREP(3) ? SS1 : (u64*)(ws + WS_TOKINFO), ws + WS_H8, LASTREP(3) ? Hb : (bf16*)(ws + WS_MACT), SS0};
        pg8::gemm_phase<pg8::EpiResidT<2>, pg8::DenseSched, true>(F.lds, 2 * DM, S, E);
    }
    SEAM(3);
    if (IN(4)) { PHASE_IDS();
#define WG_ROW(j) ((const bf16*)(ws + WS_WGU0) + (size_t)(((j) >> 7) * 256 + ((j) & 127)) * DM)
        W22 mw = md22_load(WG_ROW(bx + G * wave), WG_ROW(bx + G * wave) + (size_t)128 * DM, lane);
        meta_stage_norm(F, M1);
        for (int j = bx + G * wave; j < FF; j += G * NWAVES) {
            float g, u; md22_comp(mw, xm, lane, g, u); if (j + G * NWAVES < FF) mw = md22_load(WG_ROW(j + G * NWAVES), WG_ROW(j + G * NWAVES) + (size_t)128 * DM, lane);
            if (mlane) ACTM[mr * FF + j] = (bf16)f2bf(silu_f(g) * u); }
        __syncthreads();
#if I8_P4
        pg8::DenseSched S{T / 256, 2 * FF / 256, G, bx, (const char*)(ws + WS_H8), (const char*)(ws + WS_WGU0Q), (size_t)256 * DM, (size_t)256 * DM};
        pg8::EpiSwigluI8T<FP8_P5 != 0> E{(bf16*)(ws + WS_ACT), SS1, SS0, (const unsigned*)(F.ctl + CM_GU0)};
        pg8::gemm_phase<pg8::EpiSwigluI8T<FP8_P5 != 0>, pg8::DenseSched, true, 2, FP8_P5 != 0 ? 8 : 0>(F.lds, DM, S, E);
#else
        pg8::DenseSched S{T / 256, 2 * FF / 256, G, bx, (const char*)Hb, (const char*)(ws + WS_WGU0), (size_t)256 * DM * 2, (size_t)256 * DM * 2};
        pg8::EpiSwiglu<false> E{(bf16*)(ws + WS_ACT), SS1};
        pg8::gemm_phase<pg8::EpiSwiglu<false>, pg8::DenseSched, true>(F.lds, 2 * DM, S, E);
#endif
    }
    SEAM(4);
    if (IN(5)) { PHASE_IDS();
        const int c5 = bx + G * wave; W6 mw6{}; float mres = 0.f;
        if (c5 < DM) { mw6 = mdff_load((const bf16*)(ws + WS_WDN0) + (size_t)c5 * FF, lane); mres = M1[mr * DM + c5]; }
        meta_stage_bf16<16 * FF>(F, ACTM);
        for (int c = c5; c < DM; c += G * NWAVES) {
            if (c != c5) { mw6 = mdff_load((const bf16*)(ws + WS_WDN0) + (size_t)c * FF, lane); mres = M1[mr * DM + c]; }
            const float v = mdff_comp(mw6, xm, lane);
            if (mlane) M2[mr * DM + c] = mres + v; }
        __syncthreads();
#if FP8_P5
        pg8::DenseSched S{T / 256, 4, G, bx, (const char*)(ws + WS_ACT), (const char*)(ws + WS_WDN0Q), (size_t)256 * FF, (size_t)256 * FF};
        pg8::EpiResidT<2, true, true> E{Hb, LASTREP(5) ? SS2 : (u64*)(ws + WS_TOKINFO), LASTREP(5) ? ws + WS_H8 : ws + WS_MACT + 8 * MiB, LASTREP(5) ? Hb : (bf16*)(ws + WS_MACT), SS1, 1.f / (QS_ACT * QS_WDN), (const bf16*)(ws + WS_WSM), (int*)(ws + WS_PLX)};
        pg8::gemm_phase<pg8::EpiResidT<2, true, true>, pg8::DenseSched, true, 1>(F.lds, FF, S, E);
#else
        pg8::DenseSched S{T / 256, 4, G, bx, (const char*)(ws + WS_ACT), (const char*)(ws + WS_WDN0), (size_t)256 * FF * 2, (size_t)256 * FF * 2};
        pg8::EpiResidT<2, false, true> E{Hb, LASTREP(5) ? SS2 : (u64*)(ws + WS_TOKINFO), LASTREP(5) ? ws + WS_H8 : ws + WS_MACT + 8 * MiB, LASTREP(5) ? Hb : (bf16*)(ws + WS_MACT), SS1, 1.f, (const bf16*)(ws + WS_WSM), (int*)(ws + WS_PLX)};
        pg8::gemm_phase<pg8::EpiResidT<2, false, true>, pg8::DenseSched, true>(F.lds, 2 * FF, S, E);
#endif
    }
    SEAM(5);
    if (IN(6)) { PHASE_IDS();
#define KVF_ROW(c) (((c) < 2 * DM) ? (const bf16*)(ws + WS_WQKV1) + (size_t)(DM + (c)) * DM : (const bf16*)(ws + WS_WSM) + (size_t)((c) - 2 * DM) * DM)
        u32x4 mwa, mwb; md2_load(KVF_ROW(bx + G * wave), lane, mwa, mwb);
        const int rt0 = bx * NWAVES + wave; const bool ht0 = rt0 < T / 16; const int row0 = (ht0 ? rt0 : 0) * 16 + (lane & 15);
        const u64 ssv0 = SS2[row0]; const v4i_t* pp0 = (const v4i_t*)((const int*)(ws + WS_PLX) + (size_t)row0 * 64 + 4 * (lane >> 4)); const v4i_t pl0 = pp0[0], pl1 = pp0[4], pl2 = pp0[8], pl3 = pp0[12];
        meta_stage_norm(F, M2);
        for (int c = bx + G * wave; c < 2 * DM + NH; c += G * NWAVES) {
            const float v = md2_comp(mwa, mwb, xm, lane); if (c + G * NWAVES < 2 * DM + NH) md2_load(KVF_ROW(c + G * NWAVES), lane, mwa, mwb);
            if (mlane) {
                if (c < DM) { KMRAW[mr * DM + c] = v; if (LASTREP(6)) atomicAdd(KSQM + mr * NH + (c >> 6), to_fx(v * v)); }
                else if (c < 2 * DM) { const bf16 bv = (bf16)f2bf(v); bf16* dst = Vb + (size_t)(48 + mr) * DM + (c - DM); for (int b = 0; b < NB; ++b) dst[(size_t)b * KROWS * DM] = bv; }
                else { const int hh = c - 2 * DM; const float fl = v + F.bfg[hh]; const float ls = fminf(fl, 0.f) - __logf(1.f + __expf(-fabsf(fl)));
                    for (int b = 0; b < NB; ++b) LF[((size_t)b * NH + hh) * KROWS + 48 + mr] = ls * LOG2E; } }
        }
        { const int fr = lane & 15, fq = lane >> 4;
            for (int rt = bx * NWAVES + wave; rt < T / 16; rt += G * NWAVES) { const int row = rt * 16 + fr;
                u64 ssv = ssv0; v4i_t s4 = pl0 + pl1 + pl2 + pl3;
                if (rt != rt0) { ssv = SS2[row]; const v4i_t* pp = (const v4i_t*)((const int*)(ws + WS_PLX) + (size_t)row * 64 + 4 * fq); s4 = pp[0] + pp[4] + pp[8] + pp[12]; }
                const f32x4 a = __builtin_convertvector(s4, f32x4) * PLI;
                const float rs = frsq(from_fx(ssv) * (1.f / DM) + EPS);
#pragma unroll
                for (int i = 0; i < 4; ++i) { const int hh = 4 * fq + i; const float fl = a[i] * rs + F.bfg[hh]; const float ls = fminf(fl, 0.f) - __logf(1.f + __expf(-fabsf(fl)));
                    LF[((size_t)(row >> 11) * NH + hh) * KROWS + 64 + (row & 2047)] = ls * LOG2E; } } }
        if (F.tid < 128) ((LAS float*)(F.lds + L_X))[F.tid] = (F.tid < 64 ? F.qnb : F.kn)[F.tid & 63];
        __syncthreads();
        pg8::DenseSched S{T / 256, 12, G, bx, (const char*)(ws + WS_H8), (const char*)(ws + WS_WQKV1Q), (size_t)256 * DM, (size_t)256 * DM};
        pg8::EpiHeadNormI8W E{Qb, Kb, Vb, SS2, F.qnb, F.kn, SS1, (const unsigned*)(F.ctl + CM_QKV1)};
        pg8::gemm_phase<pg8::EpiHeadNormI8W, pg8::DenseSched, true, 2, 16>(F.lds, DM, S, E);
    }
    SEAM(6);
    if (IN(7)) { PHASE_IDS();
        for (int bh = bx; bh < NB * NH; bh += G) { const int b = bh >> 4, h = bh & 15;
            int tq_ = threadIdx.x; asm volatile("" : "+v"(tq_)); const int tid2 = tq_, lane2 = tq_ & 63, wave2 = __builtin_amdgcn_readfirstlane(tq_ >> 6);
            float lfv[5];
#pragma unroll
            for (int i = 0; i < 5; ++i) { const int kr = tid2 * 5 + i; lfv[i] = (kr >= 48 && kr < KROWS) ? (LF + (size_t)bh * KROWS)[kr] : 0.f; }
            { static_assert(NMETA * HD == 2 * NWAVES * 64, "two values per thread");
                LAS float* sc16 = (LAS float*)(F.lds + fox::LDS_NB);
                const int d = tid2 & 63, r0 = tid2 >> 6, r1 = r0 + 8;
                const float k0 = KMRAW[r0 * DM + h * HD + d], k1 = KMRAW[r1 * DM + h * HD + d], kd = F.kn[d];
                if (tid2 < NMETA) sc16[tid2] = frsq(from_fx(KSQM[tid2 * NH + h]) * (1.f / HD) + EPS);
                __syncthreads();
                Kb[((size_t)b * KROWS + 48 + r0) * DM + h * HD + d] = (bf16)f2bf(k0 * sc16[r0] * kd);
                Kb[((size_t)b * KROWS + 48 + r1) * DM + h * HD + d] = (bf16)f2bf(k1 * sc16[r1] * kd); }
            { LAS float* nb = (LAS float*)(F.lds + fox::LDS_NB); LAS float* sc = (LAS float*)(F.lds + fox::LDS_SCAN);
                float v[5]; float run = 0.f;
#pragma unroll
                for (int i = 0; i < 5; ++i) { run += lfv[i]; v[i] = run; }
                float inc = run;
#pragma unroll
                for (int o = 1; o < 64; o <<= 1) { const float t_ = __shfl_up(inc, o); if (lane2 >= o) inc += t_; }
                if (lane2 == 63) sc[wave2] = inc;
                __syncthreads();
                float base = inc - run; for (int w = 0; w < wave2; ++w) base += sc[w];
#pragma unroll
                for (int i = 0; i < 5; ++i) { const int kr = tid2 * 5 + i; if (kr < KROWS) { const float x = (kr < 48) ? -1e4f : -(base + v[i]); nb[kr] = x;
                    const unsigned hb = f2bf(x); const float r1 = x - __builtin_bit_cast(float, hb << 16); const unsigned mb = f2bf(r1); const float r2 = r1 - __builtin_bit_cast(float, mb << 16); const unsigned lb = f2bf(r2);
                    ((LAS u32x4*)(F.lds + fox::LDS_KAUG))[kr] = (u32x4){hb | (mb << 16), lb, 0u, 0u}; } }
            }
            VM_WAIT(); __syncthreads();
            for (int qb = 0; qb < SEQ / 256; ++qb) fox::attn_unit<8>(b, h, qb, Qb, Kb, Vb, Ob, (char*)lds_raw);
        }
    }
    SEAM(7);
    if (IN(8)) { PHASE_IDS();
        pg8::DenseSched S{T / 256, 4, G, bx, (const char*)Ob, (const char*)(ws + WS_WO1), (size_t)256 * DM * 2, (size_t)256 * DM * 2};
        pg8::EpiResidT<1, false, true> E{Hb, LASTREP(8) ? SS3 : (u64*)(ws + WS_TOKINFO), LASTREP(8) ? ws + WS_H8 : ws + WS_MACT + 64 * MiB, LASTREP(8) ? Hb : (bf16*)(ws + WS_MACT), nullptr, 1.f, (const bf16*)(ws + WS_WSM + 32768), (int*)(ws + WS_PLX)};
        pg8::gemm_phase<pg8::EpiResidT<1, false, true>, pg8::DenseSched, true>(F.lds, 2 * DM, S, E);
    }
    SEAM(8);
    if (IN(9)) { PHASE_IDS();
        const bool dry9 = !LASTREP(9);
        int* const list = (int*)(ws + (dry9 ? WS_MACT : WS_LIST)); float* const glist = (float*)(ws + (dry9 ? WS_MACT + 2 * MiB : WS_GLIST)); int* const tokinfo = (int*)(ws + (dry9 ? WS_MACT + 4 * MiB : WS_TOKINFO));
        gu32* const cntw = F.ctl + CW_CNT + (dry9 ? 1024 : 0);
        volatile LAS unsigned* lcnt = F.MISC + 16; volatile LAS unsigned* lbase = F.MISC + 24;
        const int fr = lane & 15, fq = lane >> 4;
        for (int ch = bx; ch < T / 128; ch += G) {
            if (F.tid < 8) lcnt[F.tid] = 0u;
            __syncthreads();
            const int row = ch * 128 + wave * 16 + fr;
            const u64 ssv3 = SS3[row];
            float lg[8];
            { const v4i_t* pp = (const v4i_t*)((const int*)(ws + WS_PLX) + (size_t)row * 64 + 16 * fq);
                v4i_t s0 = pp[0], s1 = pp[1], s2 = pp[2], s3 = pp[3];
#pragma unroll
                for (int i = 0; i < 4; ++i) { s0[i] += __shfl_xor(s0[i], 16); s1[i] += __shfl_xor(s1[i], 16); s2[i] += __shfl_xor(s2[i], 16); s3[i] += __shfl_xor(s3[i], 16);
                    s0[i] += __shfl_xor(s0[i], 32); s1[i] += __shfl_xor(s1[i], 32); s2[i] += __shfl_xor(s2[i], 32); s3[i] += __shfl_xor(s3[i], 32); }
#pragma unroll
                for (int i = 0; i < 4; ++i) { lg[i] = (float)(s0[i] + s2[i]) * PLI; lg[4 + i] = (float)(s1[i] + s3[i]) * PLI; } }
            const float rs = frsq(from_fx(ssv3) * (1.f / DM) + EPS);
            int e0 = 0; float l0 = lg[0];
#pragma unroll
            for (int e = 1; e < 8; ++e) if (lg[e] > l0) { l0 = lg[e]; e0 = e; }
            int e1 = -1; float l1 = -INFINITY;
#pragma unroll
            for (int e = 0; e < 8; ++e) if (e != e0 && lg[e] > l1) { l1 = lg[e]; e1 = e; }
            const float g0 = frcp(1.f + __expf((l1 - l0) * rs)), g1 = 1.f - g0;
            unsigned r0 = 0, r1 = 0;
            if (fq == 0) { r0 = atomicAdd((unsigned*)&lcnt[e0], 1u); r1 = atomicAdd((unsigned*)&lcnt[e1], 1u); }
            __syncthreads();
            if (F.tid < 8) lbase[F.tid] = atomicAdd((unsigned*)(cntw + 64 * F.tid), lcnt[F.tid]);
            __syncthreads();
            if (fq == 0) { const unsigned p0 = lbase[e0] + r0, p1 = lbase[e1] + r1;
                list[(size_t)e0 * T + p0] = row; glist[(size_t)e0 * T + p0] = g0; list[(size_t)e1 * T + p1] = row; glist[(size_t)e1 * T + p1] = g1;
                tokinfo[2 * row] = (int)((p0 << 3) | (unsigned)e0); tokinfo[2 * row + 1] = (int)((p1 << 3) | (unsigned)e1);
                { const float rq = rs * (1.f / (QS_H * QS_WGU)), c1 = -rq * LOG2E, k2 = frcp(rq * rq * QS_ACT);
                  ((u64*)(ws + WS_RSC))[row] = (u64)__builtin_bit_cast(unsigned, c1) | ((u64)__builtin_bit_cast(unsigned, k2) << 32); } }
            __syncthreads();
        }
    }
    SEAM(9);
    if (IN(10)) { PHASE_IDS();
        const int nM = moe_tables(F);
        pg8::MoeSched<true> S{nM, 2 * FF / 256, G, bx, (const char*)(ws + WS_H8), (const char*)(ws + WS_WGU1), 0, (size_t)256 * DM, (size_t)2 * FF * DM, (const LAS int*)(F.lds + L_TAB), (const int*)(ws + WS_LIST), (const float*)(ws + WS_GLIST)};
        pg8::EpiSwiglu<true> E{(bf16*)(ws + WS_MACT), (const u64*)(ws + WS_RSC)};
        pg8::gemm_phase<pg8::EpiSwiglu<true>, pg8::MoeSched<true>, true, 1, 8>(F.lds, DM, S, E);
    }
    SEAM(10);
    if (IN(11)) { PHASE_IDS();
        const int nM = moe_tables(F);
        int nMf, Rr, SP; pg8::moe_split(nM, 4, G, nMf, Rr, SP);
        pg8::MoeDownSched S{{nM, 4, G, bx, (const char*)(ws + WS_MACT), (const char*)(ws + WS_WDN1), (size_t)256 * FF, (size_t)256 * FF, (size_t)DM * FF, (const LAS int*)(F.lds + L_TAB), (const int*)(ws + WS_LIST), (const float*)(ws + WS_GLIST)}, nMf, Rr, SP, FF / 128};
        pg8::EpiMoE2 E{(bf16*)(ws + WS_C), (bf16*)(ws + WS_CP), nMf};
        pg8::gemm_phase<pg8::EpiMoE2, pg8::MoeDownSched, true, 1, 16>(F.lds, FF, S, E);
    }
    SEAM(11);
    if (IN(12)) { PHASE_IDS();
        const int nM12 = moe_tables(F); int nMf, Rr, SP; pg8::moe_split(nM12, 4, G, nMf, Rr, SP); (void)Rr;
        const size_t thr = (size_t)nMf * 256; const bf16* CPb = (const bf16*)(ws + WS_CP);
        auto addp = [&](u32x4 (&v)[2], size_t r) {
            if (r >= thr) { const bf16* p = CPb + (r - thr) * DM;
                float f[16];
#pragma unroll
                for (int j = 0; j < 2; ++j) { f[8 * j] = bflo(v[j].x); f[8 * j + 1] = bfhi(v[j].x); f[8 * j + 2] = bflo(v[j].y); f[8 * j + 3] = bfhi(v[j].y); f[8 * j + 4] = bflo(v[j].z); f[8 * j + 5] = bfhi(v[j].z); f[8 * j + 6] = bflo(v[j].w); f[8 * j + 7] = bfhi(v[j].w); }
                for (int s_ = 0; s_ + 1 < SP; ++s_) {
#pragma unroll
                    for (int j = 0; j < 2; ++j) { const u32x4 x = ((const GAS u32x4*)(p + (size_t)s_ * pg8::TAILR * DM) + 2 * lane)[j];
                        f[8 * j] += bflo(x.x); f[8 * j + 1] += bfhi(x.x); f[8 * j + 2] += bflo(x.y); f[8 * j + 3] += bfhi(x.y); f[8 * j + 4] += bflo(x.z); f[8 * j + 5] += bfhi(x.z); f[8 * j + 6] += bflo(x.w); f[8 * j + 7] += bfhi(x.w); } }
#pragma unroll
                for (int j = 0; j < 2; ++j) { v[j].x = cvt_pk_bf16(f[8 * j], f[8 * j + 1]); v[j].y = cvt_pk_bf16(f[8 * j + 2], f[8 * j + 3]); v[j].z = cvt_pk_bf16(f[8 * j + 4], f[8 * j + 5]); v[j].w = cvt_pk_bf16(f[8 * j + 6], f[8 * j + 7]); } } };
        const LAS int* tab = (const LAS int*)(F.lds + L_TAB); const int* tokinfo = (const int*)(ws + WS_TOKINFO); const bf16* Cb = (const bf16*)(ws + WS_C);
        const int gwv = bx * NWAVES + wave, NGW = G * NWAVES;
        for (int row0 = gwv; row0 < T; row0 += 2 * NGW) {
            const int row1 = row0 + NGW; const bool has1 = row1 < T; const int r1 = has1 ? row1 : row0;
            const u32x2 ia = *(const GAS u32x2*)(tokinfo + 2 * row0), ib = *(const GAS u32x2*)(tokinfo + 2 * r1);
            const size_t a0 = (size_t)tab[272 + (ia.x & 7)] * 256 + (ia.x >> 3), a1 = (size_t)tab[272 + (ia.y & 7)] * 256 + (ia.y >> 3);
            const size_t b0 = (size_t)tab[272 + (ib.x & 7)] * 256 + (ib.x >> 3), b1 = (size_t)tab[272 + (ib.y & 7)] * 256 + (ib.y >> 3);
            u32x4 hv[2][2], ca[2][2], cb[2][2];
#pragma unroll
            for (int j = 0; j < 2; ++j) {
                hv[0][j] = ((const GAS u32x4*)(Hb + (size_t)row0 * DM) + 2 * lane)[j]; ca[0][j] = ((const GAS u32x4*)(Cb + a0 * DM) + 2 * lane)[j]; cb[0][j] = ((const GAS u32x4*)(Cb + a1 * DM) + 2 * lane)[j];
                hv[1][j] = ((const GAS u32x4*)(Hb + (size_t)r1 * DM) + 2 * lane)[j]; ca[1][j] = ((const GAS u32x4*)(Cb + b0 * DM) + 2 * lane)[j]; cb[1][j] = ((const GAS u32x4*)(Cb + b1 * DM) + 2 * lane)[j]; }
            addp(ca[0], a0); addp(cb[0], a1); addp(ca[1], b0); addp(cb[1], b1);
#pragma unroll
            for (int t = 0; t < 2; ++t) { if (t == 1 && !has1) break;
                GAS f32x4* op = (GAS f32x4*)(F.out + (size_t)(t ? row1 : row0) * DM) + 4 * lane;
#pragma unroll
                for (int j = 0; j < 2; ++j) { const u32x4 h_ = hv[t][j], a = ca[t][j], b = cb[t][j];
                    op[2 * j] = (f32x4){bflo(h_.x) + bflo(a.x) + bflo(b.x), bfhi(h_.x) + bfhi(a.x) + bfhi(b.x), bflo(h_.y) + bflo(a.y) + bflo(b.y), bfhi(h_.y) + bfhi(a.y) + bfhi(b.y)};
                    op[2 * j + 1] = (f32x4){bflo(h_.z) + bflo(a.z) + bflo(b.z), bfhi(h_.z) + bfhi(a.z) + bfhi(b.z), bflo(h_.w) + bflo(a.w) + bflo(b.w), bfhi(h_.w) + bfhi(a.w) + bfhi(b.w)}; } }
        }
    }
#if SATMODE
    if (hi == NPHASE && sat_bad && F.bx == 0 && threadIdx.x == 0) F.out[0] = __builtin_nanf("");
#endif
#undef IN
#undef SEAM
}

#ifndef MK_PER_PHASE
#define MK_PER_PHASE 0
#endif
extern "C" void kernel_launch(void* const* d_in, const int* in_sizes, int n_in, void* d_out, int out_size, void* d_ws, size_t ws_size, hipStream_t stream) {
    static int grid = 0;
    if (grid == 0) {
        if (n_in != 20 || in_sizes[0] != T * DM || out_size != T * DM || ws_size < WS_END) { fprintf(stderr, "kernel_launch: unexpected shapes (n_in %d, in0 %d, out %d, ws %zu < %zu); nothing launched\n", n_in, n_in > 0 ? in_sizes[0] : -1, out_size, ws_size, (size_t)WS_END); grid = -1; return; }
        int dev = 0, cus = 0, per_cu = 0;
        if (hipGetDevice(&dev) != hipSuccess || hipDeviceGetAttribute(&cus, hipDeviceAttributeMultiprocessorCount, dev) != hipSuccess) { grid = -1; return; }
        if (hipFuncSetAttribute((const void*)yoco_fwd, hipFuncAttributeMaxDynamicSharedMemorySize, LDS_BYTES) != hipSuccess) { fprintf(stderr, "kernel_launch: hipFuncSetAttribute failed\n"); grid = -1; return; }
        if (hipOccupancyMaxActiveBlocksPerMultiprocessor(&per_cu, (const void*)yoco_fwd, NWAVES * 64, LDS_BYTES) != hipSuccess || per_cu < 1) { fprintf(stderr, "kernel_launch: occupancy query says %d blocks per CU\n", per_cu); per_cu = 1; }
        (void)hipGetLastError();
        grid = cus;
    }
    if (grid < 0) return;
    if (hipMemsetAsync(d_ws, 0, ZERO_BYTES, stream) != hipSuccess) { fprintf(stderr, "kernel_launch: memset failed\n"); return; }
    Args a{};
    for (int i = 0; i < 20; ++i) a.in[i] = (const float*)d_in[i];
    a.out = (float*)d_out; a.ws = (unsigned char*)d_ws; a.li = 0; a.dry = -1;
#if defined(PROBE_PHASE)
    a.ph_lo = 0; a.ph_hi = PROBE_PHASE + 1; a.li = 0; a.dry = PROBE_PHASE; hipLaunchKernelGGL(yoco_fwd, dim3(grid), dim3(NWAVES * 64), LDS_BYTES, stream, a);
    a.ph_lo = PROBE_PHASE; a.ph_hi = NPHASE; a.li = 1; a.dry = -1; hipLaunchKernelGGL(yoco_fwd, dim3(grid), dim3(NWAVES * 64), LDS_BYTES, stream, a);
#elif MK_PER_PHASE
    for (int p = 0; p < NPHASE; ++p) { a.ph_lo = p; a.ph_hi = p + 1; hipLaunchKernelGGL(yoco_fwd, dim3(grid), dim3(NWAVES * 64), LDS_BYTES, stream, a); }
#else
    a.ph_lo = 0; a.ph_hi = NPHASE; hipLaunchKernelGGL(yoco_fwd, dim3(grid), dim3(NWAVES * 64), LDS_BYTES, stream, a);
#endif
    const hipError_t le = hipPeekAtLastError();
    if (le != hipSuccess) fprintf(stderr, "kernel_launch: launch failed: %s\n", hipGetErrorName(le));
}
```
